# Optimizing an MI355X kernel written in HIP

```python
import jax, jax.numpy as jnp
from jax import lax
import numpy as np

D_MODEL = 1024
BATCH = 8
SEQ = 8192
DEPTH = 2

EPS = 1e-6
GLA_HEADS = 4
GLA_DK = 128
GLA_DV = 256
GLA_GATE_RANK = 16
GLA_GATE_TAU = 16.0
GLA_CHUNK = 64
GLA_PROJ = GLA_HEADS * (2 * GLA_DK + 2 * GLA_DV) + GLA_GATE_RANK
SWA_HEADS = 16
SWA_KV_HEADS = 4
SWA_GROUP = SWA_HEADS // SWA_KV_HEADS
SWA_HEAD_DIM = 64
SWA_WINDOW = 128
SWA_BLOCK = 128
ROT_DIM = SWA_HEAD_DIM // 4
ROPE_THETA = 500000.0
PEER_HEADS = 8
PEER_N_KEYS = 128
PEER_EXPERTS = PEER_N_KEYS * PEER_N_KEYS
PEER_TOPK = 16
PEER_QDIM = 256
PEER_BLOCK = 128

kernel_name = "yoco_gla_swa_sink_peer_block"


def rmsnorm(x, g):
    x32 = x.astype(jnp.float32)
    y = x32 * lax.rsqrt(jnp.mean(x32 * x32, axis=-1, keepdims=True) + EPS)
    return (y * g.astype(jnp.float32)).astype(x.dtype)


def modulate(x, g, shift, scale):
    return rmsnorm(x, g) * (1.0 + scale[:, None, :]) + shift[:, None, :]


def rope_tables(positions):
    inv = ROPE_THETA ** (-jnp.arange(0, ROT_DIM, 2, dtype=jnp.float32) / ROT_DIM)
    ang = positions.astype(jnp.float32)[..., None] * inv
    return jnp.cos(ang), jnp.sin(ang)


def apply_partial_rope(x, cos, sin):
    half = ROT_DIM // 2
    xr = x[..., :ROT_DIM].astype(jnp.float32)
    x1, x2 = xr[..., :half], xr[..., half:]
    c = cos[:, :, None, :]
    s = sin[:, :, None, :]
    rot = jnp.concatenate([x1 * c - x2 * s, x2 * c + x1 * s], axis=-1).astype(x.dtype)
    return jnp.concatenate([rot, x[..., ROT_DIM:]], axis=-1)


def gla_mixer(h, w_in, w_g2, b_g2, norm_g, w_out):
    bsz, s_len, _ = h.shape
    H, dk, dv, C = GLA_HEADS, GLA_DK, GLA_DV, GLA_CHUNK
    n_c = s_len // C
    proj = h @ w_in
    q, k, v, og, gl = jnp.split(proj, [H * dk, 2 * H * dk, 2 * H * dk + H * dv, 2 * H * dk + 2 * H * dv], axis=-1)
    log_a = jax.nn.log_sigmoid((gl @ w_g2 + b_g2).astype(jnp.float32)) / GLA_GATE_TAU
    shp = (bsz, n_c, C, H, dk)
    q = q.reshape(shp).astype(jnp.float32) * (dk ** -0.5)
    k = k.reshape(shp).astype(jnp.float32)
    v = v.reshape(bsz, n_c, C, H, dv).astype(jnp.float32)
    b = jnp.cumsum(log_a.reshape(shp), axis=2)
    b_last = b[:, :, -1:]
    q_t = q * jnp.exp(b)
    k_t = k * jnp.exp(-b)
    k_dec = k * jnp.exp(b_last - b)
    scores = jnp.einsum('bnchd,bnmhd->bnhcm', q_t, k_t)
    tri = jnp.tril(jnp.ones((C, C), dtype=bool))
    scores = jnp.where(tri, scores, 0.0)
    o_intra = jnp.einsum('bnhcm,bnmhe->bnche', scores, v)
    dec = jnp.exp(b_last[:, :, 0])

    def step(state, inp):
        q_n, k_n, v_n, d_n = inp
        o_n = jnp.einsum('bchd,bhde->bche', q_n, state)
        state = d_n[..., None] * state + jnp.einsum('bchd,bche->bhde', k_n, v_n)
        return state, o_n

    xs = (jnp.moveaxis(q_t, 1, 0), jnp.moveaxis(k_dec, 1, 0), jnp.moveaxis(v, 1, 0), jnp.moveaxis(dec, 1, 0))
    _, o_inter = lax.scan(step, jnp.zeros((bsz, H, dk, dv), jnp.float32), xs)
    o = (o_intra + jnp.moveaxis(o_inter, 0, 1)).reshape(bsz, s_len, H, dv)
    o = rmsnorm(o, norm_g) * jax.nn.silu(og.reshape(bsz, s_len, H, dv).astype(jnp.float32))
    return (o.reshape(bsz, s_len, H * dv) @ w_out).astype(h.dtype)


def shared_kv(h, kv_w, cos, sin):
    bsz, s_len, _ = h.shape
    kv = h @ kv_w
    k, v = jnp.split(kv, 2, axis=-1)
    k = apply_partial_rope(k.reshape(bsz, s_len, SWA_KV_HEADS, SWA_HEAD_DIM), cos, sin)
    v = v.reshape(bsz, s_len, SWA_KV_HEADS, SWA_HEAD_DIM)
    return k, v


def swa_sink_attention(h, w_q, sinks, w_out, k, v, cos, sin):
    bsz, s_len, _ = h.shape
    P = SWA_BLOCK
    n_b = s_len // P
    q = apply_partial_rope((h @ w_q).reshape(bsz, s_len, SWA_HEADS, SWA_HEAD_DIM), cos, sin)
    q = q.reshape(bsz, n_b, P, SWA_KV_HEADS, SWA_GROUP, SWA_HEAD_DIM)

    def band(t):
        prev = jnp.pad(t, ((0, 0), (P, 0), (0, 0), (0, 0)))[:, :s_len]
        shp = (bsz, n_b, P, SWA_KV_HEADS, SWA_HEAD_DIM)
        return jnp.concatenate([prev.reshape(shp), t.reshape(shp)], axis=2)

    k_band, v_band = band(k), band(v)
    s = jnp.einsum('bnqkgd,bnmkd->bnkgqm', q, k_band).astype(jnp.float32) * (SWA_HEAD_DIM ** -0.5)
    qi = jnp.arange(P)[:, None]
    mi = jnp.arange(2 * P)[None, :]
    rel = qi + P - mi
    in_window = (rel >= 0) & (rel < SWA_WINDOW)
    key_pos = jnp.arange(n_b)[:, None, None] * P - P + mi[None]
    mask = in_window[None] & (key_pos >= 0)
    s = jnp.where(mask[None, :, None, None], s, -jnp.inf)
    sink = sinks.astype(jnp.float32).reshape(SWA_KV_HEADS, SWA_GROUP)[None, None, :, :, None, None]
    m = jnp.maximum(jnp.max(s, axis=-1, keepdims=True), sink)
    p = jnp.exp(s - m)
    probs = p / (jnp.sum(p, axis=-1, keepdims=True) + jnp.exp(sink - m))
    o = jnp.einsum('bnkgqm,bnmkd->bnqkgd', probs, v_band.astype(jnp.float32))
    return (o.reshape(bsz, s_len, SWA_HEADS * SWA_HEAD_DIM) @ w_out).astype(h.dtype)


def peer(h, w_q, subkeys, u_tab, v_tab):
    bsz, s_len, d = h.shape
    half = PEER_QDIM // 2
    tokens = h.reshape(-1, PEER_BLOCK, d)

    def block(xb):
        q = (xb @ w_q).reshape(PEER_BLOCK, PEER_HEADS, PEER_QDIM)
        s1 = jnp.einsum('phd,nd->phn', q[..., :half], subkeys[0])
        s2 = jnp.einsum('phd,nd->phn', q[..., half:], subkeys[1])
        v1, i1 = lax.top_k(s1, PEER_TOPK)
        v2, i2 = lax.top_k(s2, PEER_TOPK)
        cand = (v1[..., :, None] + v2[..., None, :]).reshape(PEER_BLOCK, PEER_HEADS, PEER_TOPK * PEER_TOPK)
        cs, ci = lax.top_k(cand, PEER_TOPK)
        e = (jnp.take_along_axis(i1, ci // PEER_TOPK, axis=-1) * PEER_N_KEYS
             + jnp.take_along_axis(i2, ci % PEER_TOPK, axis=-1))
        g = jax.nn.softmax(cs.astype(jnp.float32), axis=-1)
        u = u_tab[e]
        a = jax.nn.gelu(jnp.einsum('pd,phkd->phk', xb, u).astype(jnp.float32), approximate=False)
        return jnp.einsum('phk,phkd->pd', g * a, v_tab[e].astype(jnp.float32)).astype(xb.dtype)

    return lax.map(block, tokens).reshape(bsz, s_len, d)


def setup_inputs(seed: int = 0) -> dict:
    key = jax.random.key(seed)
    ks = jax.random.split(key, 24)
    n_a = DEPTH // 2
    n_b = DEPTH - n_a
    D = D_MODEL
    f32 = jnp.float32

    def nrm(k, shape, scale):
        return jax.random.normal(k, shape, f32) * scale

    positions = (jax.random.randint(ks[2], (BATCH, 1), 0, 4096, dtype=jnp.int32)
                 + jnp.arange(SEQ, dtype=jnp.int32)[None, :])
    return {
        "x": nrm(ks[0], (BATCH, SEQ, D), 1.0),
        "c": nrm(ks[1], (BATCH, D), 1.0),
        "positions": positions,
        "mod_w": nrm(ks[3], (DEPTH, D, 6 * D), 0.5 * D ** -0.5),
        "mod_b": nrm(ks[4], (DEPTH, 6 * D), 0.02),
        "norm_g": 1.0 + nrm(ks[5], (DEPTH, 2, D), 0.02),
        "gla_w_in": nrm(ks[6], (n_a, D, GLA_PROJ), D ** -0.5),
        "gla_w_g2": nrm(ks[7], (n_a, GLA_GATE_RANK, GLA_HEADS * GLA_DK), GLA_GATE_RANK ** -0.5),
        "gla_b_g2": nrm(ks[8], (n_a, GLA_HEADS * GLA_DK), 0.1),
        "gla_norm_g": 1.0 + nrm(ks[9], (n_a, GLA_DV), 0.02),
        "gla_w_out": nrm(ks[10], (n_a, GLA_HEADS * GLA_DV, D), (GLA_HEADS * GLA_DV) ** -0.5),
        "kv_mod_w": nrm(ks[11], (D, 2 * D), 0.5 * D ** -0.5),
        "kv_mod_b": nrm(ks[12], (2 * D,), 0.02),
        "kv_norm_g": 1.0 + nrm(ks[13], (D,), 0.02),
        "kv_w": nrm(ks[14], (D, 2 * SWA_KV_HEADS * SWA_HEAD_DIM), D ** -0.5),
        "swa_w_q": nrm(ks[15], (n_b, D, SWA_HEADS * SWA_HEAD_DIM), D ** -0.5),
        "swa_sinks": nrm(ks[16], (n_b, SWA_HEADS), 0.5),
        "swa_w_out": nrm(ks[17], (n_b, SWA_HEADS * SWA_HEAD_DIM, D), (SWA_HEADS * SWA_HEAD_DIM) ** -0.5),
        "peer_w_q": nrm(ks[18], (DEPTH, D, PEER_HEADS * PEER_QDIM), D ** -0.5),
        "peer_subkeys": nrm(ks[19], (DEPTH, 2, PEER_N_KEYS, PEER_QDIM // 2), (PEER_QDIM // 2) ** -0.5),
        "peer_u": nrm(ks[20], (DEPTH, PEER_EXPERTS, D), D ** -0.5),
        "peer_v": nrm(ks[21], (DEPTH, PEER_EXPERTS, D), PEER_HEADS ** -0.5),
        "final_norm_g": 1.0 + nrm(ks[22], (D,), 0.02),
    }


def reference(x, c, positions, mod_w, mod_b, norm_g, gla_w_in, gla_w_g2, gla_b_g2, gla_norm_g,
              gla_w_out, kv_mod_w, kv_mod_b, kv_norm_g, kv_w, swa_w_q, swa_sinks, swa_w_out,
              peer_w_q, peer_subkeys, peer_u, peer_v, final_norm_g):
    n_a = DEPTH // 2
    cos, sin = rope_tables(positions)
    c_act = jax.nn.silu(c)
    k_sh, v_sh = None, None
    for l in range(DEPTH):
        mod = c_act @ mod_w[l] + mod_b[l]
        sh1, sc1, g1, sh2, sc2, g2 = jnp.split(mod, 6, axis=-1)
        h = modulate(x, norm_g[l, 0], sh1, sc1)
        if l < n_a:
            y = gla_mixer(h, gla_w_in[l], gla_w_g2[l], gla_b_g2[l], gla_norm_g[l], gla_w_out[l])
        else:
            j = l - n_a
            y = swa_sink_attention(h, swa_w_q[j], swa_sinks[j], swa_w_out[j], k_sh, v_sh, cos, sin)
        x = x + (g1[:, None, :] * y).astype(x.dtype)
        h = modulate(x, norm_g[l, 1], sh2, sc2)
        y = peer(h, peer_w_q[l], peer_subkeys[l], peer_u[l], peer_v[l])
        x = x + (g2[:, None, :] * y).astype(x.dtype)
        if l == n_a - 1:
            kv_mod = c_act @ kv_mod_w + kv_mod_b
            kv_shift, kv_scale = jnp.split(kv_mod, 2, axis=-1)
            k_sh, v_sh = shared_kv(modulate(x, kv_norm_g, kv_shift, kv_scale), kv_w, cos, sin)
    return rmsnorm(x, final_norm_g)
```

```cpp
#include <hip/hip_runtime.h>
#include <hip/hip_cooperative_groups.h>
#include <cstdio>
#include <cstdint>
namespace cg = cooperative_groups;

typedef unsigned short bf16_t;
typedef short bf16x8 __attribute__((ext_vector_type(8)));
typedef float f32x4 __attribute__((ext_vector_type(4)));
typedef float f32x16 __attribute__((ext_vector_type(16)));
typedef __bf16 bf16v2 __attribute__((ext_vector_type(2)));

constexpr int D = 1024, NB = 8, SEQ = 8192, T = NB * SEQ;
constexpr int GLA_NPROJ = 3088;
constexpr int NEXP = 16384;
constexpr float EPS = 1e-6f;
constexpr int NTHR = 512, NWAVE = 8;

constexpr size_t MiB = 1024ull * 1024ull;
constexpr size_t OFF_MOD = 64 * 1024;
constexpr size_t OFF_CMB = 576 * 1024;
constexpr size_t OFF_WB = 1 * MiB;
constexpr size_t WB_MAIN = 0;
constexpr size_t WB_V = WB_MAIN + 2304ull * 2048;
constexpr size_t WB_WOUT = WB_V + 1024ull * 2048;
constexpr size_t WB_KVK = WB_WOUT + 1024ull * 2048;
constexpr size_t WB_KVV = WB_KVK + 256ull * 2048;
constexpr size_t WB_SWAQ = WB_KVV + 256ull * 2048;
constexpr size_t WB_SWAO = WB_SWAQ + 1024ull * 2048;
constexpr size_t WB_PWQ = WB_SWAO + 1024ull * 2048;
constexpr size_t WB_SUBK = WB_PWQ + 2ull * 2048 * 2048;
constexpr float PWQ8_SCALE = 64.f, H8_SCALE = 4.f, O8_SCALE = 16.f, ON8_SCALE = 4.f;
constexpr size_t WB_END = WB_SUBK + 2ull * 2 * 128 * 128 * 2;
static_assert(WB_END <= 23 * MiB, "weights region");
constexpr size_t OFF_TBU = 24 * MiB;
constexpr size_t OFF_TBV = OFF_TBU + 64 * MiB;
constexpr float TBU_SCALE = 92.f, TBV_SCALE = 90.f;
constexpr size_t OFF_R0 = 152 * MiB;
constexpr size_t OFF_A0 = 408 * MiB;
constexpr size_t OFF_A1 = 536 * MiB;
constexpr size_t OFF_A2 = 664 * MiB;
constexpr size_t OFF_A3 = 792 * MiB;
constexpr size_t OFF_RTE = 920 * MiB;
constexpr size_t OFF_ROPE = 952 * MiB;
constexpr size_t WS_NEED = 984 * MiB;

struct Params {
    const float* x; const float* c; const int* pos; const float* mod_w; const float* mod_b; const float* norm_g;
    const float* gla_w_in; const float* gla_w_g2; const float* gla_b_g2; const float* gla_norm_g; const float* gla_w_out;
    const float* kv_mod_w; const float* kv_mod_b; const float* kv_norm_g; const float* kv_w;
    const float* swa_w_q; const float* swa_sinks; const float* swa_w_out;
    const float* peer_w_q; const float* peer_subkeys; const float* peer_u; const float* peer_v; const float* final_norm_g;
    float* out; char* ws;
};

constexpr int LDS_BYTES = 144 * 1024;
#ifndef REP_PEER
#define REP_PEER 1
#endif
#ifndef REP_ROUTE
#define REP_ROUTE 1
#endif
#ifndef REP_SWA
#define REP_SWA 1
#endif
#ifndef REP_G2
#define REP_G2 1
#endif
#ifndef REP_MOD
#define REP_MOD 1
#endif
#ifndef REP_G1
#define REP_G1 1
#endif
#ifndef REP_G3
#define REP_G3 1
#endif

__device__ __forceinline__ unsigned pack2(float lo, float hi) { bf16v2 v; v.x = (__bf16)lo; v.y = (__bf16)hi; return __builtin_bit_cast(unsigned, v); }
__device__ __forceinline__ float bf_lo(unsigned u) { return __uint_as_float(u << 16); }
__device__ __forceinline__ float bf_hi(unsigned u) { return __uint_as_float(u & 0xFFFF0000u); }
__device__ __forceinline__ float wave_sum(float v) {
#pragma unroll
    for (int o = 32; o > 0; o >>= 1) v += __shfl_xor(v, o);
    return v;
}
__device__ __forceinline__ int opaque_tid(int wv) { int t; asm volatile("v_mbcnt_lo_u32_b32 %0, -1, 0\n\tv_mbcnt_hi_u32_b32 %0, -1, %0\n\tv_lshl_or_b32 %0, %1, 6, %0" : "=&v"(t) : "s"(wv)); return t; }
__device__ __forceinline__ unsigned q4(float v) { return (unsigned)__float2int_rn(fminf(fmaxf(v, -7.f), 7.f)) & 15u; }
__device__ __forceinline__ unsigned q8(float v) { return (unsigned)__float2int_rn(fminf(fmaxf(v, -127.f), 127.f)) & 255u; }
__device__ __forceinline__ float silu(float v) { return v / (1.f + __expf(-v)); }
__device__ __forceinline__ float dpp_max16(float v) {
    v = fmaxf(v, __builtin_bit_cast(float, __builtin_amdgcn_update_dpp(0, __builtin_bit_cast(int, v), 0xB1, 0xF, 0xF, true)));
    v = fmaxf(v, __builtin_bit_cast(float, __builtin_amdgcn_update_dpp(0, __builtin_bit_cast(int, v), 0x4E, 0xF, 0xF, true)));
    v = fmaxf(v, __builtin_bit_cast(float, __builtin_amdgcn_update_dpp(0, __builtin_bit_cast(int, v), 0x141, 0xF, 0xF, true)));
    v = fmaxf(v, __builtin_bit_cast(float, __builtin_amdgcn_update_dpp(0, __builtin_bit_cast(int, v), 0x140, 0xF, 0xF, true)));
    return v;
}
__device__ __forceinline__ float dpp_sum16(float v) {
    v += __builtin_bit_cast(float, __builtin_amdgcn_update_dpp(0, __builtin_bit_cast(int, v), 0xB1, 0xF, 0xF, true));
    v += __builtin_bit_cast(float, __builtin_amdgcn_update_dpp(0, __builtin_bit_cast(int, v), 0x4E, 0xF, 0xF, true));
    v += __builtin_bit_cast(float, __builtin_amdgcn_update_dpp(0, __builtin_bit_cast(int, v), 0x141, 0xF, 0xF, true));
    v += __builtin_bit_cast(float, __builtin_amdgcn_update_dpp(0, __builtin_bit_cast(int, v), 0x140, 0xF, 0xF, true));
    return v;
}

#define XB_TMO      128
#define XB_XCNT(j)  (256  + 64 * (j))
#define XB_XSUB(j)  (1280 + 64 * (j))
#define XB_XGEN(j)  (2304 + 64 * (j))
#define XB_TOP      3328
#define XB_TOPGEN   3392
#define XCD_BAR_WORDS 3456
#define XB_SPIN_CAP (1u << 20)
#define LAS __attribute__((address_space(3)))
__device__ __forceinline__ unsigned xb_ld(unsigned* p)              { return __hip_atomic_load(p, __ATOMIC_RELAXED, __HIP_MEMORY_SCOPE_AGENT); }
__device__ __forceinline__ unsigned xb_add(unsigned* p, unsigned v) { return __hip_atomic_fetch_add(p, v, __ATOMIC_RELAXED, __HIP_MEMORY_SCOPE_AGENT); }
__device__ __forceinline__ unsigned xb_xcc_id() { return (unsigned)__builtin_amdgcn_s_getreg((3 << 11) | 20) & 0xFu; }
#define XB_SPIN(cond, bar) do { unsigned _sp = 0; while (cond) { __builtin_amdgcn_s_sleep(1); \
    if ((++_sp & 255u) == 0u) { if (xb_ld(&(bar)[XB_TMO])) break; if (_sp > XB_SPIN_CAP) { atomicAdd(&(bar)[XB_TMO], 1u); break; } } } } while (0)
struct XcdBarrier { unsigned* bar; unsigned x; volatile LAS unsigned* st; };
__device__ __forceinline__ XcdBarrier xcd_barrier_post(unsigned* bar, volatile LAS unsigned* st) {
    XcdBarrier b; b.bar = bar; b.x = xb_xcc_id(); b.st = st;
    if (threadIdx.x == 0) (void)xb_add(&bar[XB_XCNT(b.x)], 1u);
    return b;
}
__device__ __forceinline__ void xcd_barrier_complete(unsigned* bar, unsigned x, unsigned& nloc, unsigned& nx) {
    const unsigned G = gridDim.x * gridDim.y * gridDim.z;
    unsigned sum, cnt, mine, sp = 0u;
    for (;;) {
        sum = 0u; cnt = 0u; mine = 0u;
#pragma unroll
        for (unsigned j = 0; j < 16; ++j) { const unsigned c = xb_ld(&bar[XB_XCNT(j)]); sum += c; cnt += (c > 0u) ? 1u : 0u; mine = (j == x) ? c : mine; }
        if (sum == G) break;
        __builtin_amdgcn_s_sleep(1);
        if ((++sp & 255u) == 0u) { if (xb_ld(&bar[XB_TMO])) break; if (sp > XB_SPIN_CAP) { atomicAdd(&bar[XB_TMO], 1u); break; } }
    }
    nloc = mine > 0u ? mine : 1u; nx = cnt > 0u ? cnt : 1u;
}
__device__ __forceinline__ void xcd_barrier(const XcdBarrier& b) {
    asm volatile("s_waitcnt vmcnt(0)" ::: "memory");
    __syncthreads();
    if (threadIdx.x == 0) {
        unsigned* bar = b.bar;
        __builtin_amdgcn_s_waitcnt(0);
        unsigned nloc = b.st[0], nx = b.st[1];
        if (nloc == 0u) { xcd_barrier_complete(bar, b.x, nloc, nx); b.st[0] = nloc; b.st[1] = nx; }
        const unsigned old = xb_add(&bar[XB_XSUB(b.x)], 1u);
        const unsigned gen = old / nloc;
        if (old + 1u == (gen + 1u) * nloc) {
            __builtin_amdgcn_fence(__ATOMIC_RELEASE, "agent");
            asm volatile("s_waitcnt vmcnt(0)" ::: "memory");
            const unsigned og = xb_add(&bar[XB_TOP], 1u);
            const unsigned tg = og / nx;
            if (og + 1u == (tg + 1u) * nx) xb_add(&bar[XB_TOPGEN], 1u);
            else XB_SPIN(xb_ld(&bar[XB_TOPGEN]) == tg, bar);
            __builtin_amdgcn_fence(__ATOMIC_ACQUIRE, "agent");
            xb_add(&bar[XB_XGEN(b.x)], 1u);
            asm volatile("s_waitcnt vmcnt(0)" ::: "memory");
        } else {
            XB_SPIN(xb_ld(&bar[XB_XGEN(b.x)]) == gen, bar);
            __builtin_amdgcn_fence(__ATOMIC_ACQUIRE, "agent");
            asm volatile("s_waitcnt vmcnt(0)" ::: "memory");
        }
    }
    __syncthreads();
}

namespace pg8 {
#define PG8_LAS __attribute__((address_space(3)))
constexpr int BM = 256, BK = 64, HALF = 128, HTB = HALF * BK * 2, STAGE_BYTES = 8 * HTB, NXCD = 8, WGM = 2;
__device__ __forceinline__ int lds_byte(int r, int c) { const int st = (r >> 4) * 2 + (c >> 5), rr = r & 15, cc = c & 31, ob = rr * 64 + cc * 2; return st * 1024 + (ob ^ (((ob >> 9) & 1) << 5)); }
__device__ __forceinline__ void stage_rc(int b, int& R, int& C) { const int st = b / 1024, sb = b % 1024, swz = sb ^ (((sb >> 9) & 1) << 5); R = (st >> 1) * 16 + swz / 64; C = (st & 1) * 32 + (swz % 64) / 2; }
typedef int i32x8 __attribute__((ext_vector_type(8)));
typedef int i32x4 __attribute__((ext_vector_type(4)));
template <bool FP8> struct Frag;
template <> struct Frag<false> { bf16x8 k[2]; __device__ __forceinline__ void set2(bf16x8 x, bf16x8 y) { k[0] = x; k[1] = y; } };
template <> struct Frag<true> { i32x8 v; __device__ __forceinline__ void set2(bf16x8 x, bf16x8 y) { v = __builtin_shufflevector(__builtin_bit_cast(i32x4, x), __builtin_bit_cast(i32x4, y), 0, 1, 2, 3, 4, 5, 6, 7); } };
template <bool FP8> __device__ __forceinline__ f32x4 frag_mma(const Frag<FP8>& b, const Frag<FP8>& a, f32x4 c);
template <> __device__ __forceinline__ f32x4 frag_mma<false>(const Frag<false>& b, const Frag<false>& a, f32x4 c) {
    c = __builtin_amdgcn_mfma_f32_16x16x32_bf16(b.k[0], a.k[0], c, 0, 0, 0);
    return __builtin_amdgcn_mfma_f32_16x16x32_bf16(b.k[1], a.k[1], c, 0, 0, 0);
}
template <> __device__ __forceinline__ f32x4 frag_mma<true>(const Frag<true>& b, const Frag<true>& a, f32x4 c) {
    return __builtin_amdgcn_mfma_scale_f32_16x16x128_f8f6f4(b.v, a.v, c, 0, 0, 0, 0x7F7F7F7F, 0, 0x7F7F7F7F);
}
struct Unit { int pm, pn; };
struct Gemm { const bf16_t* A; const bf16_t* Bt; int M, N, K; };
struct StaticOrder {
    int nM, nN, nwg, G, c;
    __device__ void init(int M, int N, int G_, int c_) { nM = M / BM; nN = N / BM; nwg = nM * nN; G = G_; c = c_; }
    __device__ bool next(int i, Unit& u) const {
        const long L = (long)i * G + c; if (L >= nwg) return false;
        int wgid = (int)L; { const int q = nwg / NXCD, r = nwg % NXCD, xcd = wgid % NXCD, off = wgid / NXCD; wgid = (xcd < r ? xcd * (q + 1) : r * (q + 1) + (xcd - r) * q) + off; }
        const int nig = WGM * nN, gid = wgid / nig, fm = gid * WGM, gsz = (nM - fm) < WGM ? (nM - fm) : WGM;
        u.pm = fm + ((wgid % nig) % gsz); u.pn = (wgid % nig) / gsz; return true;
    }
};
template <class Epi, bool FP8 = false>
__device__ __forceinline__ void gemm_phase(const int wv, PG8_LAS unsigned char* lds, const Gemm g, const StaticOrder& S, const Epi& E) {
    const int tid = opaque_tid(wv), wid = wv, lane = tid & 63, wr = wid >> 2, wc = wid & 3, fr = lane & 15, fq = lane >> 4;
    const int K = g.K, nt = K / BK;
    unsigned voffA[2], voffB[2];
#pragma unroll
    for (int i = 0; i < 2; ++i) { int R, C; stage_rc(tid * 16 + i * 8192, R, C); const int rho = R & 31, Rb = (R & ~31) + 8 * ((rho & 15) >> 2) + 4 * (rho >> 4) + (rho & 3);
        voffA[i] = (unsigned)(R * K + C) * 2u; voffB[i] = (unsigned)(Rb * K + C) * 2u; }
    const size_t kstep = (size_t)(BK * 2);
    const size_t hstep = (size_t)HALF * K * 2;
    const size_t tstep = 2 * hstep;
    const unsigned ldsw = (unsigned)wid * 1024u;
    const int aoff = lds_byte(wr * 64 + fr, fq * 8), boff = lds_byte(wc * 32 + fr, fq * 8);
    PG8_LAS unsigned char* ldsB = lds + 4 * HTB + boff; asm volatile("" : "+v"(ldsB));
#define PG8_SA(b, h) (((b) * 2 + (h)) * HTB)
#define PG8_SB(b, h) ((4 + (b) * 2 + (h)) * HTB)
#define PG8_STAGE(bufoff, gbase, voff) do { _Pragma("unroll") for (int _i = 0; _i < 2; ++_i) { unsigned _vo = (voff)[_i]; asm volatile("" : "+v"(_vo)); \
        __builtin_amdgcn_global_load_lds((const unsigned*)((const char*)(gbase) + _vo), (PG8_LAS unsigned*)(lds + (bufoff) + ldsw + _i * 8192), 16, 0, 0); } } while (0)
#define PG8_LDA(dst, b, h) do { _Pragma("unroll") for (int m = 0; m < 4; ++m) dst[m].set2(*(const PG8_LAS bf16x8*)(lds + PG8_SA(b, h) + aoff + m * 2048), *(const PG8_LAS bf16x8*)(lds + PG8_SA(b, h) + aoff + m * 2048 + 1024)); } while (0)
#define PG8_LDB(dst, b, h) do { _Pragma("unroll") for (int n = 0; n < 2; ++n) dst[n].set2(*(const PG8_LAS bf16x8*)(ldsB + PG8_SA(b, h) + n * 2048), *(const PG8_LAS bf16x8*)(ldsB + PG8_SA(b, h) + n * 2048 + 1024)); } while (0)
#define PG8_MMA(ai, bj, At, Bt) do { __builtin_amdgcn_s_setprio(1); _Pragma("unroll") for (int m = 0; m < 4; ++m) _Pragma("unroll") for (int n = 0; n < 2; ++n) \
        acc[ai][bj][m][n] = frag_mma<FP8>(Bt[n], At[m], acc[ai][bj][m][n]); __builtin_amdgcn_s_setprio(0); } while (0)
#define PG8_WAIT_V(n) asm volatile("s_waitcnt vmcnt(" #n ")" ::: "memory")
#define PG8_WAIT_L(n) asm volatile("s_waitcnt lgkmcnt(" #n ")" ::: "memory")
#define PG8_BAR __builtin_amdgcn_s_barrier()
#define PG8_SCHED __builtin_amdgcn_sched_barrier(0)
    Unit cur, nxt; int ui = 0;
    if (!S.next(0, cur)) return;
    f32x4 acc[2][2][4][2];
#pragma unroll
    for (int a = 0; a < 2; ++a)
#pragma unroll
        for (int b = 0; b < 2; ++b)
#pragma unroll
            for (int m = 0; m < 4; ++m)
#pragma unroll
                for (int n = 0; n < 2; ++n) acc[a][b][m][n] = (f32x4){0.f, 0.f, 0.f, 0.f};
    Frag<FP8> At[4], B0[2], B1[2];
    const char* cA = (const char*)g.A + (size_t)cur.pm * tstep; const char* cB = (const char*)g.Bt + (size_t)cur.pn * tstep;
    PG8_STAGE(PG8_SB(0, 0), cB, voffB); PG8_STAGE(PG8_SA(0, 0), cA, voffA); PG8_STAGE(PG8_SB(0, 1), cB + hstep, voffB); PG8_STAGE(PG8_SA(0, 1), cA + hstep, voffA);
    if (wr == 1) PG8_BAR;
    PG8_WAIT_V(4); PG8_BAR;
    PG8_STAGE(PG8_SB(1, 0), cB + kstep, voffB); PG8_STAGE(PG8_SA(1, 0), cA + kstep, voffA); PG8_STAGE(PG8_SB(1, 1), cB + hstep + kstep, voffB);
    PG8_WAIT_V(6); PG8_BAR;
    for (;;) {
        const bool has_next = S.next(ui + 1, nxt);
        const char* nA = has_next ? (const char*)g.A + (size_t)nxt.pm * tstep : cA; const char* nB = has_next ? (const char*)g.Bt + (size_t)nxt.pn * tstep : cB;
        _Pragma("unroll 1") for (int t = 0; t < nt; t += 2) {
            const bool last = (t == nt - 2);
            const char* a1 = cA + (size_t)(t + 1) * kstep;
            const char* a2 = last ? nA : cA + (size_t)(t + 2) * kstep; const char* b2 = last ? nB : cB + (size_t)(t + 2) * kstep;
            const char* a3 = a2 + kstep; const char* b3 = b2 + kstep;
            PG8_LDB(B0, 0, 0); PG8_SCHED; PG8_LDA(At, 0, 0); PG8_STAGE(PG8_SA(1, 1), a1 + hstep, voffA);
            PG8_WAIT_L(8); PG8_BAR; PG8_WAIT_L(0); PG8_MMA(0, 0, At, B0); PG8_BAR; PG8_SCHED;
            PG8_LDB(B1, 0, 1); PG8_STAGE(PG8_SB(0, 0), b2, voffB);
            PG8_BAR; PG8_WAIT_L(0); PG8_MMA(0, 1, At, B1); PG8_BAR;
            PG8_LDA(At, 0, 1); PG8_STAGE(PG8_SA(0, 0), a2, voffA);
            PG8_BAR; PG8_WAIT_L(0); PG8_MMA(1, 0, At, B0); PG8_BAR; PG8_SCHED;
            PG8_STAGE(PG8_SB(0, 1), b2 + hstep, voffB);
            PG8_WAIT_V(6); PG8_BAR; PG8_MMA(1, 1, At, B1); PG8_BAR;
            PG8_LDB(B0, 1, 0); PG8_SCHED; PG8_LDA(At, 1, 0); PG8_STAGE(PG8_SA(0, 1), a2 + hstep, voffA);
            PG8_WAIT_L(8); PG8_BAR; PG8_WAIT_L(0); PG8_MMA(0, 0, At, B0); PG8_BAR; PG8_SCHED;
            PG8_LDB(B1, 1, 1); PG8_STAGE(PG8_SB(1, 0), b3, voffB);
            PG8_BAR; PG8_WAIT_L(0); PG8_MMA(0, 1, At, B1); PG8_BAR;
            PG8_LDA(At, 1, 1); PG8_STAGE(PG8_SA(1, 0), a3, voffA);
            PG8_BAR; PG8_WAIT_L(0); PG8_MMA(1, 0, At, B0); PG8_BAR; PG8_SCHED;
            PG8_STAGE(PG8_SB(1, 1), b3 + hstep, voffB);
            PG8_WAIT_V(6); PG8_BAR; PG8_MMA(1, 1, At, B1); PG8_BAR;
        }
        { const int t2 = opaque_tid(wv); E(acc, cur, wr, wc, t2 & 15, (t2 >> 4) & 3); }
        if (!has_next) break;
#pragma unroll
        for (int a = 0; a < 2; ++a)
#pragma unroll
            for (int b = 0; b < 2; ++b)
#pragma unroll
                for (int m = 0; m < 4; ++m)
#pragma unroll
                    for (int n = 0; n < 2; ++n) acc[a][b][m][n] = (f32x4){0.f, 0.f, 0.f, 0.f};
        cur = nxt; cA = nA; cB = nB; ++ui;
    }
    PG8_WAIT_V(0);
    if (wr == 0) PG8_BAR;
    PG8_BAR;
#undef PG8_SA
#undef PG8_SB
#undef PG8_STAGE
#undef PG8_LDA
#undef PG8_LDB
#undef PG8_MMA
#undef PG8_WAIT_V
#undef PG8_WAIT_L
#undef PG8_BAR
#undef PG8_SCHED
}
}

typedef unsigned u32x2 __attribute__((ext_vector_type(2)));
template <int CTRL> __device__ __forceinline__ unsigned dpp_quad(unsigned v) { return (unsigned)__builtin_amdgcn_mov_dpp((int)v, CTRL, 0xf, 0xf, true); }
template <class F> struct EpiAdapt {
    F f;
    __device__ __forceinline__ void operator()(const f32x4 (&acc)[2][2][4][2], const pg8::Unit& u, int wr, int wc, int fr, int fq) const {
        const int b = fr & 3, a4 = fr & 12;
        const bool odd = (b & 1) != 0, hi = (b & 2) != 0;
#pragma unroll
        for (int ai = 0; ai < 2; ++ai)
#pragma unroll
            for (int bj = 0; bj < 2; ++bj) {
                const int row0 = 256 * u.pm + 128 * ai + 64 * wr, col0 = 256 * u.pn + 128 * bj + 32 * wc;
                unsigned s[4][4];
#pragma unroll
                for (int m = 0; m < 4; ++m) { const uint4 o = f.pack(row0 + 16 * m + fr, col0 + 8 * fq, acc[ai][bj][m][0], acc[ai][bj][m][1]); s[m][0] = o.x; s[m][1] = o.y; s[m][2] = o.z; s[m][3] = o.w; }
#pragma unroll
                for (int d = 0; d < 4; ++d) {
                    u32x2 r;
                    r = __builtin_amdgcn_permlane16_swap(s[0][d], s[1][d], false, false); s[0][d] = r.x; s[1][d] = r.y;
                    r = __builtin_amdgcn_permlane16_swap(s[2][d], s[3][d], false, false); s[2][d] = r.x; s[3][d] = r.y;
                    r = __builtin_amdgcn_permlane32_swap(s[0][d], s[2][d], false, false); s[0][d] = r.x; s[2][d] = r.y;
                    r = __builtin_amdgcn_permlane32_swap(s[1][d], s[3][d], false, false); s[1][d] = r.x; s[3][d] = r.y;
                }
#pragma unroll
                for (int d = 0; d < 4; ++d) {
#pragma unroll
                    for (int j0 = 0; j0 < 4; j0 += 2) {
                        const unsigned recv = dpp_quad<0xB1>(odd ? s[j0][d] : s[j0 + 1][d]);
                        s[j0][d] = odd ? recv : s[j0][d]; s[j0 + 1][d] = odd ? s[j0 + 1][d] : recv;
                    }
#pragma unroll
                    for (int j0 = 0; j0 < 2; ++j0) {
                        const unsigned recv = dpp_quad<0x4E>(hi ? s[j0][d] : s[j0 + 2][d]);
                        s[j0][d] = hi ? recv : s[j0][d]; s[j0 + 2][d] = hi ? s[j0 + 2][d] : recv;
                    }
                }
#pragma unroll
                for (int j = 0; j < 4; ++j) {
                    void* a = f.addr(row0 + 16 * fq + a4 + j, col0 + 8 * b);
                    if (a) *(uint4*)a = make_uint4(s[j][0], s[j][1], s[j][2], s[j][3]);
                }
                __builtin_amdgcn_sched_barrier(0);
            }
    }
};
#ifndef REP_GEMM
#define REP_GEMM 1
#endif
template <class F>
__device__ __forceinline__ void run_gemm(const int wv, char* lds, const bf16_t* A, const bf16_t* Bt, int M, int N, const F& f) {
    pg8::StaticOrder S; S.init(M, N, gridDim.x, blockIdx.x);
    _Pragma("unroll 1") for (int rep = 0; rep < REP_GEMM; ++rep)
    pg8::gemm_phase(wv, (PG8_LAS unsigned char*)lds, pg8::Gemm{A, Bt, M, N, 1024}, S, EpiAdapt<F>{f});
}

template <class F>
__device__ __forceinline__ void run_gemm8(const int wv, char* lds, const unsigned char* A8, const unsigned char* Bt8, int M, int N, const F& f) {
    pg8::StaticOrder S; S.init(M, N, gridDim.x, blockIdx.x);
    pg8::gemm_phase<EpiAdapt<F>, true>(wv, (PG8_LAS unsigned char*)lds, pg8::Gemm{(const bf16_t*)A8, (const bf16_t*)Bt8, M, N, 512}, S, EpiAdapt<F>{f});
}
__device__ __forceinline__ uint4 pack8(f32x4 a, f32x4 b) { uint4 o; o.x = pack2(a[0], a[1]); o.y = pack2(a[2], a[3]); o.z = pack2(b[0], b[1]); o.w = pack2(b[2], b[3]); return o; }
struct EpiRowBf16 {
    bf16_t* dst; int ld;
    __device__ __forceinline__ uint4 pack(int m, int n, f32x4 v0, f32x4 v1) const { return pack8(v0, v1); }
    __device__ __forceinline__ void* addr(int m, int n) const { return dst + (size_t)m * ld + n; }
};
struct EpiRowBf16S {
    bf16_t* dst; int ld; float scale;
    __device__ __forceinline__ uint4 pack(int m, int n, f32x4 v0, f32x4 v1) const { return pack8(v0 * scale, v1 * scale); }
    __device__ __forceinline__ void* addr(int m, int n) const { return dst + (size_t)m * ld + n; }
};
struct EpiInMain {
    bf16_t* Q; bf16_t* K; bf16_t* OG; float* GL;
    __device__ __forceinline__ uint4 pack(int m, int n, f32x4 v0, f32x4 v1) const {
        if (n >= 2048 && n < 2064) { *(f32x4*)(GL + (size_t)m * 16 + (n - 2048)) = v0; *(f32x4*)(GL + (size_t)m * 16 + (n - 2048) + 4) = v1; }
        return pack8(v0, v1);
    }
    __device__ __forceinline__ void* addr(int m, int n) const {
        return (n < 512) ? Q + (size_t)m * 512 + n : (n < 1024) ? K + (size_t)m * 512 + (n - 512) : (n < 2048) ? OG + (size_t)m * 1024 + (n - 1024) : nullptr;
    }
};
struct EpiVT {
    bf16_t* dst; int ncols; float scale;
    __device__ __forceinline__ uint4 pack(int r, int tok, f32x4 v0, f32x4 v1) const { return pack8(v0 * scale, v1 * scale); }
    __device__ __forceinline__ void* addr(int r, int tok) const { const int b = tok >> 13, s = tok & (SEQ - 1); return dst + ((size_t)b * ncols + r) * SEQ + s; }
};
template <bool XIN_BF16> struct EpiResid {
    const void* xin; const float* gate; int gstride; bf16_t* xout; float vs;
    __device__ __forceinline__ void* addr(int m, int n) const { return xout + (size_t)m * D + n; }
    __device__ __forceinline__ uint4 pack(int m, int n, f32x4 v0, f32x4 v1) const {
        const int b = m >> 13;
        f32x4 x0, x1;
        if (XIN_BF16) { const uint4 u = *(const uint4*)((const bf16_t*)xin + (size_t)m * D + n); x0 = (f32x4){bf_lo(u.x), bf_hi(u.x), bf_lo(u.y), bf_hi(u.y)}; x1 = (f32x4){bf_lo(u.z), bf_hi(u.z), bf_lo(u.w), bf_hi(u.w)}; }
        else { x0 = *(const f32x4*)((const float*)xin + (size_t)m * D + n); x1 = *(const f32x4*)((const float*)xin + (size_t)m * D + n + 4); }
        const f32x4 g0 = *(const f32x4*)(gate + (size_t)b * gstride + n), g1 = *(const f32x4*)(gate + (size_t)b * gstride + n + 4);
        return pack8(x0 + (g0 * vs) * v0, x1 + (g1 * vs) * v1);
    }
};
struct EpiRopeBf16 {
    bf16_t* dst; int ld; float scale; const float* rope;
    __device__ __forceinline__ void* addr(int m, int n) const { return dst + (size_t)m * ld + n; }
    __device__ __forceinline__ uint4 pack(int m, int n, f32x4 v0, f32x4 v1) const {
        const int hd = n & 63;
        if (hd < 16) {
            const int i = hd >> 1;
            const float4 c = *(const float4*)(rope + (size_t)m * 16 + i), s = *(const float4*)(rope + (size_t)m * 16 + 8 + i);
            const float a0 = v0[0] * c.x - v0[1] * s.x, b0 = v0[1] * c.x + v0[0] * s.x;
            const float a1 = v0[2] * c.y - v0[3] * s.y, b1 = v0[3] * c.y + v0[2] * s.y;
            const float a2 = v1[0] * c.z - v1[1] * s.z, b2 = v1[1] * c.z + v1[0] * s.z;
            const float a3 = v1[2] * c.w - v1[3] * s.w, b3 = v1[3] * c.w + v1[2] * s.w;
            v0 = (f32x4){a0, b0, a1, b1}; v1 = (f32x4){a2, b2, a3, b3};
        }
        return pack8(v0 * scale, v1 * scale);
    }
};

__device__ __forceinline__ void phase_prep(const int wv, const Params& p, char* lds) {
    const int tid = opaque_tid(wv), G = gridDim.x;
    float* modv = (float*)(p.ws + OFF_MOD);
    float* kvmod = modv + 2 * 8 * 6144;
    {
        float* cact = (float*)lds;
        float* red = cact + 8192;
        for (int item = blockIdx.x; item < 256; item += G) {
            for (int i = tid; i < 8192; i += NTHR) cact[i] = silu(p.c[i]);
            __syncthreads();
            const int cl = tid & 63, kp = tid >> 6;
            const int j = item * 56 + (cl < 56 ? cl : 55);
            const float* W; const float* bias; float* o; int ld, col;
            if (j < 12288) { int l = j / 6144; col = j % 6144; ld = 6144; W = p.mod_w + (size_t)l * 1024 * 6144; bias = p.mod_b + l * 6144; o = modv + l * 8 * 6144; }
            else { col = j - 12288; ld = 2048; W = p.kv_mod_w; bias = p.kv_mod_b; o = kvmod; }
            float acc[8];
#pragma unroll
            for (int b = 0; b < 8; ++b) acc[b] = 0.f;
#pragma unroll 8
            for (int kk = 0; kk < 128; ++kk) {
                const int k = kp * 128 + kk;
                const float w = W[(size_t)k * ld + col];
#pragma unroll
                for (int b = 0; b < 8; ++b) acc[b] += cact[b * 1024 + k] * w;
            }
#pragma unroll
            for (int b = 0; b < 8; ++b) red[(kp * 8 + b) * 64 + cl] = acc[b];
            __syncthreads();
            {
                const int b = tid >> 6;
                float s = 0.f;
#pragma unroll
                for (int q = 0; q < 8; ++q) s += red[(q * 8 + b) * 64 + cl];
                if (cl < 56) o[b * ld + col] = s + bias[col];
            }
            __syncthreads();
        }
    }
    {
        float* tile = (float*)lds;
        const int NT_TOTAL = 86;
        for (int item = blockIdx.x; item < NT_TOTAL * 16; item += G) {
            const int nt = item >> 4, kt = item & 15;
            const float* src; int ldsrc, col0, nvalid, perm = 0, ntl, f8 = 0; size_t dsto;
            if (nt < 4)       { ntl = nt;      src = p.gla_w_in;  ldsrc = GLA_NPROJ; col0 = 0;    nvalid = 512;  dsto = WB_MAIN; }
            else if (nt < 8)  { ntl = nt - 4;  src = p.gla_w_in;  ldsrc = GLA_NPROJ; col0 = 512;  nvalid = 512;  dsto = WB_MAIN + 512ull * 2048; }
            else if (nt < 16) { ntl = nt - 8;  src = p.gla_w_in;  ldsrc = GLA_NPROJ; col0 = 2048; nvalid = 1024; dsto = WB_MAIN + 1024ull * 2048; }
            else if (nt < 18) { ntl = nt - 16; src = p.gla_w_in;  ldsrc = GLA_NPROJ; col0 = 3072; nvalid = 16;   dsto = WB_MAIN + 2048ull * 2048; }
            else if (nt < 26) { ntl = nt - 18; src = p.gla_w_in;  ldsrc = GLA_NPROJ; col0 = 1024; nvalid = 1024; dsto = WB_V; }
            else if (nt < 34) { ntl = nt - 26; src = p.gla_w_out; ldsrc = 1024; col0 = 0;   nvalid = 1024; dsto = WB_WOUT; f8 = 1; }
            else if (nt < 36) { ntl = nt - 34; src = p.kv_w;      ldsrc = 512;  col0 = 0;   nvalid = 256;  dsto = WB_KVK; perm = 1; f8 = 1; }
            else if (nt < 38) { ntl = nt - 36; src = p.kv_w;      ldsrc = 512;  col0 = 256; nvalid = 256;  dsto = WB_KVV; f8 = 1; }
            else if (nt < 46) { ntl = nt - 38; src = p.swa_w_q;   ldsrc = 1024; col0 = 0;   nvalid = 1024; dsto = WB_SWAQ; perm = 1; f8 = 1; }
            else if (nt < 54) { ntl = nt - 46; src = p.swa_w_out; ldsrc = 1024; col0 = 0;   nvalid = 1024; dsto = WB_SWAO; f8 = 1; }
            else if (nt < 70) { ntl = nt - 54; src = p.peer_w_q;  ldsrc = 2048; col0 = 0;   nvalid = 2048; dsto = WB_PWQ; }
            else              { ntl = nt - 70; src = p.peer_w_q + (size_t)1024 * 2048; ldsrc = 2048; col0 = 0; nvalid = 2048; dsto = WB_PWQ + 2048ull * 2048; f8 = 1; }
            bf16_t* dst = (bf16_t*)(p.ws + OFF_WB + dsto);
            const int n0 = ntl * 128, k0 = kt * 64;
            {
                const int nn = tid & 127;
                int n = n0 + nn;
                if (perm) { const int hd = n & 63; if (hd < 16) n = (n & ~63) + ((hd & 1) ? 8 + (hd >> 1) : (hd >> 1)); }
#pragma unroll
                for (int i = 0; i < 16; ++i) {
                    const int kk = (tid >> 7) + 4 * i;
                    tile[kk * 129 + nn] = (n < nvalid) ? src[(size_t)(k0 + kk) * ldsrc + col0 + n] : 0.f;
                }
            }
            __syncthreads();
            if (f8) {
                const int nn = tid >> 2, kc = (tid & 3) * 16;
                unsigned o[4];
#pragma unroll
                for (int q = 0; q < 4; ++q) {
                    const int lo = __builtin_amdgcn_cvt_pk_fp8_f32(tile[(kc + 4 * q + 0) * 129 + nn] * PWQ8_SCALE, tile[(kc + 4 * q + 1) * 129 + nn] * PWQ8_SCALE, 0, false);
                    o[q] = (unsigned)__builtin_amdgcn_cvt_pk_fp8_f32(tile[(kc + 4 * q + 2) * 129 + nn] * PWQ8_SCALE, tile[(kc + 4 * q + 3) * 129 + nn] * PWQ8_SCALE, lo, true);
                }
                *(uint4*)((unsigned char*)dst + (size_t)(n0 + nn) * 1024 + k0 + kc) = make_uint4(o[0], o[1], o[2], o[3]);
            } else
#pragma unroll
            for (int i = 0; i < 2; ++i) {
                const int nn = (tid >> 3) + 64 * i, kc = (tid & 7) * 8;
                uint4 o;
                o.x = pack2(tile[(kc + 0) * 129 + nn], tile[(kc + 1) * 129 + nn]);
                o.y = pack2(tile[(kc + 2) * 129 + nn], tile[(kc + 3) * 129 + nn]);
                o.z = pack2(tile[(kc + 4) * 129 + nn], tile[(kc + 5) * 129 + nn]);
                o.w = pack2(tile[(kc + 6) * 129 + nn], tile[(kc + 7) * 129 + nn]);
                *(uint4*)(dst + (size_t)(n0 + nn) * 1024 + k0 + kc) = o;
            }
            __syncthreads();
        }
    }
    {
        const size_t gt = (size_t)blockIdx.x * NTHR + tid, gs = (size_t)G * NTHR;
        const size_t NTAB = (size_t)2 * NEXP * 1024 / 16;
        {
            const float* src = p.peer_v;
            uint4* dst = (uint4*)(p.ws + OFF_TBV);
            for (size_t i = gt; i < NTAB; i += gs) {
                unsigned o[4];
#pragma unroll
                for (int q = 0; q < 4; ++q) {
                    const size_t row = i >> 6; const int ch = (int)(i & 63), c = ch >> 4, li = ch & 15;
                    const float4 a = ((const float4*)src)[row * 256 + 64 * c + 16 * q + li];
                    o[q] = q8(a.x * TBV_SCALE) | (q8(a.y * TBV_SCALE) << 8) | (q8(a.z * TBV_SCALE) << 16) | (q8(a.w * TBV_SCALE) << 24);
                }
                dst[i] = make_uint4(o[0], o[1], o[2], o[3]);
            }
        }
        {
            const float* src = p.peer_u;
            uint4* dst = (uint4*)(p.ws + OFF_TBU);
            for (size_t i = gt; i < NTAB / 2; i += gs) {
                unsigned o[4];
#pragma unroll
                for (int q = 0; q < 4; ++q) {
                    const float4 a = ((const float4*)src)[8 * i + 2 * q], b = ((const float4*)src)[8 * i + 2 * q + 1];
                    o[q] = q4(a.x * TBU_SCALE) | (q4(a.y * TBU_SCALE) << 4) | (q4(a.z * TBU_SCALE) << 8) | (q4(a.w * TBU_SCALE) << 12)
                         | (q4(b.x * TBU_SCALE) << 16) | (q4(b.y * TBU_SCALE) << 20) | (q4(b.z * TBU_SCALE) << 24) | (q4(b.w * TBU_SCALE) << 28);
                }
                dst[i] = make_uint4(o[0], o[1], o[2], o[3]);
            }
        }
        {
            float* rope = (float*)(p.ws + OFF_ROPE);
            for (size_t i = gt; i < (size_t)T * 8; i += gs) {
                const int t = (int)(i >> 3), f = (int)(i & 7);
                const float ang = (float)p.pos[t] * exp2f(-(float)f * 2.3664460711655218f);
                float s, c; sincosf(ang, &s, &c);
                rope[(size_t)t * 16 + f] = c; rope[(size_t)t * 16 + 8 + f] = s;
            }
        }
        uint4* dsk = (uint4*)(p.ws + OFF_WB + WB_SUBK);
        for (size_t i = gt; i < 65536 / 8; i += gs) {
            float4 a = ((const float4*)p.peer_subkeys)[2 * i], b = ((const float4*)p.peer_subkeys)[2 * i + 1];
            constexpr float SKS = 1.f;
            uint4 o; o.x = pack2(a.x * SKS, a.y * SKS); o.y = pack2(a.z * SKS, a.w * SKS); o.z = pack2(b.x * SKS, b.y * SKS); o.w = pack2(b.z * SKS, b.w * SKS);
            dsk[i] = o;
        }
    }
}

template <bool XIN_BF16>
__device__ __forceinline__ void phase_modulate(const int wv, const void* xin, const float* g, const float* shift, const float* scale, int bstride, bf16_t* out, unsigned char* out8 = nullptr) {
    const int tid_ = opaque_tid(wv), lane = tid_ & 63, wid = tid_ >> 6;
    const int gw = blockIdx.x * NWAVE + wid, nw = gridDim.x * NWAVE;
    for (int t0 = gw * 2; t0 < T * REP_MOD; t0 += nw * 2) {
        const int t = t0 & (T - 1);
        const int b = t >> 13;
        float4 v[2][4]; float ss[2] = {0.f, 0.f};
#pragma unroll
        for (int r = 0; r < 2; ++r) {
            if (XIN_BF16) {
                const uint2* xr = (const uint2*)((const bf16_t*)xin + (size_t)(t + r) * D);
#pragma unroll
                for (int j = 0; j < 4; ++j) { const uint2 u = xr[lane + 64 * j]; v[r][j] = make_float4(bf_lo(u.x), bf_hi(u.x), bf_lo(u.y), bf_hi(u.y)); }
            } else {
                const float4* xr = (const float4*)((const float*)xin + (size_t)(t + r) * D);
#pragma unroll
                for (int j = 0; j < 4; ++j) v[r][j] = xr[lane + 64 * j];
            }
        }
#pragma unroll
        for (int r = 0; r < 2; ++r)
#pragma unroll
            for (int j = 0; j < 4; ++j) ss[r] += v[r][j].x * v[r][j].x + v[r][j].y * v[r][j].y + v[r][j].z * v[r][j].z + v[r][j].w * v[r][j].w;
        ss[0] = wave_sum(ss[0]); ss[1] = wave_sum(ss[1]);
        const float rinv[2] = {rsqrtf(ss[0] * (1.f / D) + EPS), rsqrtf(ss[1] * (1.f / D) + EPS)};
#pragma unroll
        for (int j = 0; j < 4; ++j) {
            const float4 gg = ((const float4*)g)[lane + 64 * j];
            const float4 sc = ((const float4*)(scale + (size_t)b * bstride))[lane + 64 * j];
            const float4 sh = ((const float4*)(shift + (size_t)b * bstride))[lane + 64 * j];
            const float m0 = gg.x * (1.f + sc.x), m1 = gg.y * (1.f + sc.y), m2 = gg.z * (1.f + sc.z), m3 = gg.w * (1.f + sc.w);
#pragma unroll
            for (int r = 0; r < 2; ++r) {
                const float h0 = v[r][j].x * rinv[r] * m0 + sh.x, h1 = v[r][j].y * rinv[r] * m1 + sh.y, h2 = v[r][j].z * rinv[r] * m2 + sh.z, h3 = v[r][j].w * rinv[r] * m3 + sh.w;
                uint2 o;
                o.x = pack2(h0, h1);
                o.y = pack2(h2, h3);
                ((uint2*)(out + (size_t)(t + r) * D))[lane + 64 * j] = o;
                if (out8) {
                    const int lo = __builtin_amdgcn_cvt_pk_fp8_f32(h0 * H8_SCALE, h1 * H8_SCALE, 0, false);
                    ((unsigned*)(out8 + (size_t)(t + r) * D))[lane + 64 * j] = (unsigned)__builtin_amdgcn_cvt_pk_fp8_f32(h2 * H8_SCALE, h3 * H8_SCALE, lo, true);
                }
            }
        }
    }
}

__device__ __forceinline__ float logsigmoidf(float z) { return fminf(z, 0.f) - __logf(1.f + __expf(-fabsf(z))); }
constexpr int G1LD = 136;
__device__ __forceinline__ void phase_gla_g1(const int wv, const Params& p, char* lds, const float* GL, bf16_t* Pm, float* DEC) {
    const int tid = opaque_tid(wv), lane = tid & 63, sub = tid >> 8, t8 = tid & 255, wid4 = (tid >> 6) & 3;
    bf16_t* Q = (bf16_t*)(p.ws + OFF_A1); const bf16_t* K = Q + (size_t)T * 512;
    bf16_t* KD = (bf16_t*)(p.ws + OFF_A0);
    bf16_t* QT = KD + (size_t)T * 512;
    float* gl_s = (float*)(lds + sub * 40960);
    float* tot_s = gl_s + 1024;
    bf16_t* qt_s = (bf16_t*)(tot_s + 256);
    bf16_t* kt_s = qt_s + 64 * G1LD;
    const int d = t8 & 127, half = t8 >> 7;
#define G1_BARRIER() do { asm volatile("s_waitcnt lgkmcnt(0)" ::: "memory"); __builtin_amdgcn_s_barrier(); asm volatile("" ::: "memory"); } while (0)
    const int NIT = (T / 64) * 2 * REP_G1;
    uint4 pq0, pq1, pq2, pq3, pk0, pk1, pk2, pk3; float4 pg;
#define G1_LOAD(q_, k_, i_, t_, h_) do { const int idx_ = t8 + 256 * (i_), row_ = idx_ >> 4, ch_ = idx_ & 15; \
        q_ = *(const uint4*)(Q + (size_t)((t_) + row_) * 512 + (h_) * 128 + ch_ * 8); k_ = *(const uint4*)(K + (size_t)((t_) + row_) * 512 + (h_) * 128 + ch_ * 8); } while (0)
#define G1_STAGE(q_, k_, i_) do { const int idx_ = t8 + 256 * (i_), row_ = idx_ >> 4, ch_ = idx_ & 15; *(uint4*)(qt_s + row_ * G1LD + ch_ * 8) = q_; *(uint4*)(kt_s + row_ * G1LD + ch_ * 8) = k_; } while (0)
    {
        const int item = (blockIdx.x % ((T / 64) * 2)) * 2 + sub, ci = item >> 2, h = item & 3, t0 = ci * 64;
        pg = ((const float4*)(GL + (size_t)t0 * 16))[t8];
        G1_LOAD(pq0, pk0, 0, t0, h); G1_LOAD(pq1, pk1, 1, t0, h); G1_LOAD(pq2, pk2, 2, t0, h); G1_LOAD(pq3, pk3, 3, t0, h);
    }
    int hcur = -1; float w2[16]; float bias = 0.f;
    for (int pi0 = blockIdx.x; pi0 < NIT; pi0 += gridDim.x) {
        const int pi = pi0 % ((T / 64) * 2);
        const int item = pi * 2 + sub;
        const int ci = item >> 2, h = item & 3, t0 = ci * 64;
        ((float4*)gl_s)[t8] = pg;
        G1_STAGE(pq0, pk0, 0); G1_STAGE(pq1, pk1, 1); G1_STAGE(pq2, pk2, 2); G1_STAGE(pq3, pk3, 3);
        {
            const int pn = ((pi0 + (int)gridDim.x < NIT) ? pi0 + (int)gridDim.x : pi0) % ((T / 64) * 2);
            const int itn = pn * 2 + sub, cn = itn >> 2, hn = itn & 3, tn = cn * 64;
            pg = ((const float4*)(GL + (size_t)tn * 16))[t8];
            G1_LOAD(pq0, pk0, 0, tn, hn); G1_LOAD(pq1, pk1, 1, tn, hn); G1_LOAD(pq2, pk2, 2, tn, hn); G1_LOAD(pq3, pk3, 3, tn, hn);
        }
        if (h != hcur) {
#pragma unroll
            for (int r = 0; r < 16; ++r) w2[r] = p.gla_w_g2[r * 512 + h * 128 + d];
            bias = p.gla_b_g2[h * 128 + d];
            hcur = h;
        }
        G1_BARRIER();
        float la[32]; float tot = 0.f;
#pragma unroll
        for (int i = 0; i < 32; ++i) {
            const int m = half * 32 + i; float z = bias;
#pragma unroll
            for (int r4 = 0; r4 < 4; ++r4) {
                const float4 g4 = ((const float4*)gl_s)[m * 4 + r4];
                z += g4.x * w2[4 * r4] + g4.y * w2[4 * r4 + 1] + g4.z * w2[4 * r4 + 2] + g4.w * w2[4 * r4 + 3];
            }
            la[i] = logsigmoidf(z) * (1.f / 16.f); tot += la[i];
        }
        tot_s[half * 128 + d] = tot;
        G1_BARRIER();
        const float tot0 = tot_s[d], tot1 = tot_s[128 + d];
        const float blast = tot0 + tot1;
        float cum = half ? tot0 : 0.f;
        bf16_t* kdw = KD + (size_t)item * 8192 + (size_t)d * 64 + half * 32;
#pragma unroll
        for (int i8 = 0; i8 < 4; ++i8) {
            float kd[8];
#pragma unroll
            for (int ii = 0; ii < 8; ++ii) {
                const int i = i8 * 8 + ii, m = half * 32 + i;
                cum += la[i];
                const float qv = __uint_as_float((unsigned)qt_s[m * G1LD + d] << 16);
                const float kv = __uint_as_float((unsigned)kt_s[m * G1LD + d] << 16);
                const float qt = qv * 0.08838834764831845f * __expf(cum);
                const float ktv = kv * __expf(-cum);
                kd[ii] = kv * __expf(blast - cum);
                qt_s[m * G1LD + d] = (bf16_t)(pack2(qt, 0.f) & 0xFFFFu);
                kt_s[m * G1LD + d] = (bf16_t)(pack2(ktv, 0.f) & 0xFFFFu);
            }
            uint4 o; o.x = pack2(kd[0], kd[1]); o.y = pack2(kd[2], kd[3]); o.z = pack2(kd[4], kd[5]); o.w = pack2(kd[6], kd[7]);
            *(uint4*)(kdw + i8 * 8) = o;
        }
        if (half == 0) DEC[(size_t)item * 128 + d] = __expf(blast);
        G1_BARRIER();
#pragma unroll
        for (int i = 0; i < 4; ++i) {
            const int idx = t8 + 256 * i, row = idx >> 4, ch = idx & 15;
            *(uint4*)(QT + (size_t)(t0 + row) * 512 + h * 128 + ch * 8) = *(const uint4*)(qt_s + row * G1LD + ch * 8);
        }
        {
            const int fr = lane & 15, fq = lane >> 4;
            bf16x8 qb[4];
#pragma unroll
            for (int ks = 0; ks < 4; ++ks) qb[ks] = *(const bf16x8*)(qt_s + (16 * wid4 + fr) * G1LD + 32 * ks + 8 * fq);
            const int c = 16 * wid4 + fr;
            bf16_t* prow = Pm + (size_t)item * 4096 + (size_t)c * 64;
#pragma unroll
            for (int mt = 0; mt < 4; ++mt) {
                f32x4 acc = (f32x4){0.f, 0.f, 0.f, 0.f};
                if (mt <= wid4) {
#pragma unroll
                    for (int ks = 0; ks < 4; ++ks) {
                        const bf16x8 ka = *(const bf16x8*)(kt_s + (16 * mt + fr) * G1LD + 32 * ks + 8 * fq);
                        acc = __builtin_amdgcn_mfma_f32_16x16x32_bf16(ka, qb[ks], acc, 0, 0, 0);
                    }
                }
                const int mb = 16 * mt + 4 * fq;
                float v0 = (mb + 0 <= c) ? acc[0] : 0.f, v1 = (mb + 1 <= c) ? acc[1] : 0.f, v2 = (mb + 2 <= c) ? acc[2] : 0.f, v3 = (mb + 3 <= c) ? acc[3] : 0.f;
                uint2 o; o.x = pack2(v0, v1); o.y = pack2(v2, v3);
                *(uint2*)(prow + mb) = o;
            }
        }
        G1_BARRIER();
    }
}

constexpr int G2LD = 136, G2S = 72;
constexpr int G2_VT = 0, G2_P = G2_VT + 32 * G2S * 2, G2_Q = G2_P + 64 * G2S * 2, G2_KD = G2_Q + 64 * G2LD * 2, G2_DEC = G2_KD + 128 * G2S * 2, G2_STAGE = G2_DEC + 512;
static_assert(G2_STAGE % 16 == 0 && 2 * 32 * G2LD * 2 + 2 * G2_STAGE <= LDS_BYTES - 16, "G2 LDS");
struct G2Piece { const char* src; int stride; int dst; };
__device__ __forceinline__ G2Piece g2_piece(int c, const bf16_t* VT, const bf16_t* Pm, const bf16_t* Q, const bf16_t* KD, const float* DEC, int b, int h, int sl) {
    const size_t item0 = ((size_t)(b * 128) * 4 + h);
    const size_t t0 = (size_t)b * SEQ;
    G2Piece r;
    if (c < 256) { const int row = c >> 3, ch = c & 7; r.src = (const char*)(VT + ((size_t)b * 1024 + h * 256 + sl * 32 + row) * SEQ + ch * 8); r.stride = 64 * 2; r.dst = G2_VT + (row * G2S + ch * 8) * 2; }
    else if (c < 768) { const int cc = c - 256, row = cc >> 3, ch = cc & 7; r.src = (const char*)(Pm + item0 * 4096 + row * 64 + ch * 8); r.stride = 4 * 4096 * 2; r.dst = G2_P + (row * G2S + ch * 8) * 2; }
    else if (c < 1792) { const int cc = c - 768, row = cc >> 4, ch = cc & 15; r.src = (const char*)(Q + (t0 + row) * 512 + h * 128 + ch * 8); r.stride = 64 * 512 * 2; r.dst = G2_Q + (row * G2LD + ch * 8) * 2; }
    else if (c < 2816) { const int cc = c - 1792, row = cc >> 3, ch = cc & 7; r.src = (const char*)(KD + item0 * 8192 + row * 64 + ch * 8); r.stride = 4 * 8192 * 2; r.dst = G2_KD + (row * G2S + ch * 8) * 2; }
    else { const int cc = c - 2816; r.src = (const char*)(DEC + item0 * 128 + cc * 4); r.stride = 4 * 128 * 4; r.dst = G2_DEC + cc * 16; }
    return r;
}
__device__ __forceinline__ void phase_gla_g2(const int wv, const Params& p, char* lds, const bf16_t* Pm, const float* DEC, bf16_t* O) {
    const int tid = opaque_tid(wv), lane = tid & 63, wid = tid >> 6, fr = lane & 15, fq = lane >> 4;
    const int mo = wid & 1, ct = wid >> 1;
    const bf16_t* KD = (const bf16_t*)(p.ws + OFF_A0);
    const bf16_t* Q = KD + (size_t)T * 512;
    const bf16_t* VT = (const bf16_t*)(p.ws + OFF_A2);
    bf16_t* sT = (bf16_t*)lds;
    char* stage0 = lds + 2 * 32 * G2LD * 2;
    for (int item0 = blockIdx.x; item0 < 256 * REP_G2; item0 += gridDim.x) {
        const int item = item0 & 255;
        const int xcd = item & 7, yy = item >> 3, bh = xcd * 4 + (yy >> 3), sl = yy & 7;
        const int b = bh >> 2, h = bh & 3;
        __syncthreads();
        for (int i = tid; i < 2 * 32 * G2LD / 2; i += NTHR) ((unsigned*)sT)[i] = 0u;
        f32x4 s[2];
        s[0] = (f32x4){0.f, 0.f, 0.f, 0.f}; s[1] = (f32x4){0.f, 0.f, 0.f, 0.f};
        uint4 ra0, ra1, ra2, ra3, ra4, ra5, rb0, rb1, rb2, rb3, rb4, rb5;
        const G2Piece pc0 = g2_piece(min(tid + NTHR * 0, 2847), VT, Pm, Q, KD, DEC, b, h, sl);
        const G2Piece pc1 = g2_piece(min(tid + NTHR * 1, 2847), VT, Pm, Q, KD, DEC, b, h, sl);
        const G2Piece pc2 = g2_piece(min(tid + NTHR * 2, 2847), VT, Pm, Q, KD, DEC, b, h, sl);
        const G2Piece pc3 = g2_piece(min(tid + NTHR * 3, 2847), VT, Pm, Q, KD, DEC, b, h, sl);
        const G2Piece pc4 = g2_piece(min(tid + NTHR * 4, 2847), VT, Pm, Q, KD, DEC, b, h, sl);
        const G2Piece pc5 = g2_piece(min(tid + NTHR * 5, 2847), VT, Pm, Q, KD, DEC, b, h, sl);
        ra0 = *(const uint4*)(pc0.src + (size_t)(0) * pc0.stride);
        ra1 = *(const uint4*)(pc1.src + (size_t)(0) * pc1.stride);
        ra2 = *(const uint4*)(pc2.src + (size_t)(0) * pc2.stride);
        ra3 = *(const uint4*)(pc3.src + (size_t)(0) * pc3.stride);
        ra4 = *(const uint4*)(pc4.src + (size_t)(0) * pc4.stride);
        ra5 = *(const uint4*)(pc5.src + (size_t)(0) * pc5.stride);
        *(uint4*)(stage0 + pc0.dst) = ra0;
        *(uint4*)(stage0 + pc1.dst) = ra1;
        *(uint4*)(stage0 + pc2.dst) = ra2;
        *(uint4*)(stage0 + pc3.dst) = ra3;
        *(uint4*)(stage0 + pc4.dst) = ra4;
        *(uint4*)(stage0 + pc5.dst) = ra5;
        rb0 = *(const uint4*)(pc0.src + (size_t)(1) * pc0.stride);
        rb1 = *(const uint4*)(pc1.src + (size_t)(1) * pc1.stride);
        rb2 = *(const uint4*)(pc2.src + (size_t)(1) * pc2.stride);
        rb3 = *(const uint4*)(pc3.src + (size_t)(1) * pc3.stride);
        rb4 = *(const uint4*)(pc4.src + (size_t)(1) * pc4.stride);
        rb5 = *(const uint4*)(pc5.src + (size_t)(1) * pc5.stride);
        __syncthreads();
        for (int n2 = 0; n2 < 128; n2 += 2) {
          {
            const int n = n2;
            const char* st = stage0; char* stn = stage0 + G2_STAGE;
            const int nl = min(n + 2, 127);
            ra0 = *(const uint4*)(pc0.src + (size_t)(nl) * pc0.stride);
            ra1 = *(const uint4*)(pc1.src + (size_t)(nl) * pc1.stride);
            ra2 = *(const uint4*)(pc2.src + (size_t)(nl) * pc2.stride);
            ra3 = *(const uint4*)(pc3.src + (size_t)(nl) * pc3.stride);
            ra4 = *(const uint4*)(pc4.src + (size_t)(nl) * pc4.stride);
            ra5 = *(const uint4*)(pc5.src + (size_t)(nl) * pc5.stride);
            const bf16_t* vT_s = (const bf16_t*)(st + G2_VT); const bf16_t* P_s = (const bf16_t*)(st + G2_P);
            const bf16_t* q_s = (const bf16_t*)(st + G2_Q); const bf16_t* kd_s = (const bf16_t*)(st + G2_KD);
            const bf16_t* sr = sT + (n & 1) * (32 * G2LD);
            bf16_t* sw = sT + ((n + 1) & 1) * (32 * G2LD);
            bf16x8 va[2][2];
#pragma unroll
            for (int nt = 0; nt < 2; ++nt)
#pragma unroll
                for (int ks = 0; ks < 2; ++ks) va[nt][ks] = *(const bf16x8*)(vT_s + (16 * nt + fr) * G2S + 32 * ks + 8 * fq);
            f32x4 o = (f32x4){0.f, 0.f, 0.f, 0.f};
#pragma unroll
            for (int ks = 0; ks < 2; ++ks) {
                const bf16x8 pb = *(const bf16x8*)(P_s + (16 * ct + fr) * G2S + 32 * ks + 8 * fq);
                const bf16x8 vo = *(const bf16x8*)(vT_s + (16 * mo + fr) * G2S + 32 * ks + 8 * fq);
                o = __builtin_amdgcn_mfma_f32_16x16x32_bf16(vo, pb, o, 0, 0, 0);
            }
#pragma unroll
            for (int ks = 0; ks < 4; ++ks) {
                const bf16x8 sa = *(const bf16x8*)(sr + (16 * mo + fr) * G2LD + 32 * ks + 8 * fq);
                const bf16x8 qb = *(const bf16x8*)(q_s + (16 * ct + fr) * G2LD + 32 * ks + 8 * fq);
                o = __builtin_amdgcn_mfma_f32_16x16x32_bf16(sa, qb, o, 0, 0, 0);
            }
            {
                uint2 ov; ov.x = pack2(o[0], o[1]); ov.y = pack2(o[2], o[3]);
                *(uint2*)(O + ((size_t)b * SEQ + n * 64 + 16 * ct + fr) * 1024 + h * 256 + sl * 32 + 16 * mo + 4 * fq) = ov;
            }
            const f32x4 dv = *(const f32x4*)(st + G2_DEC + (16 * wid + 4 * fq) * 4);
            bf16x8 ka[2];
#pragma unroll
            for (int ks = 0; ks < 2; ++ks) ka[ks] = *(const bf16x8*)(kd_s + (16 * wid + fr) * G2S + 32 * ks + 8 * fq);
#pragma unroll
            for (int nt = 0; nt < 2; ++nt) {
                f32x4 a = s[nt] * dv;
#pragma unroll
                for (int ks = 0; ks < 2; ++ks) a = __builtin_amdgcn_mfma_f32_16x16x32_bf16(ka[ks], va[nt][ks], a, 0, 0, 0);
                s[nt] = a;
                uint2 sv; sv.x = pack2(a[0], a[1]); sv.y = pack2(a[2], a[3]);
                *(uint2*)(sw + (16 * nt + fr) * G2LD + 16 * wid + 4 * fq) = sv;
            }
            *(uint4*)(stn + pc0.dst) = rb0;
            *(uint4*)(stn + pc1.dst) = rb1;
            *(uint4*)(stn + pc2.dst) = rb2;
            *(uint4*)(stn + pc3.dst) = rb3;
            *(uint4*)(stn + pc4.dst) = rb4;
            *(uint4*)(stn + pc5.dst) = rb5;
            __syncthreads();
          }
          {
            const int n = n2 + 1;
            const char* st = stage0 + G2_STAGE; char* stn = stage0;
            const int nl = min(n + 2, 127);
            rb0 = *(const uint4*)(pc0.src + (size_t)(nl) * pc0.stride);
            rb1 = *(const uint4*)(pc1.src + (size_t)(nl) * pc1.stride);
            rb2 = *(const uint4*)(pc2.src + (size_t)(nl) * pc2.stride);
            rb3 = *(const uint4*)(pc3.src + (size_t)(nl) * pc3.stride);
            rb4 = *(const uint4*)(pc4.src + (size_t)(nl) * pc4.stride);
            rb5 = *(const uint4*)(pc5.src + (size_t)(nl) * pc5.stride);
            const bf16_t* vT_s = (const bf16_t*)(st + G2_VT); const bf16_t* P_s = (const bf16_t*)(st + G2_P);
            const bf16_t* q_s = (const bf16_t*)(st + G2_Q); const bf16_t* kd_s = (const bf16_t*)(st + G2_KD);
            const bf16_t* sr = sT + (n & 1) * (32 * G2LD);
            bf16_t* sw = sT + ((n + 1) & 1) * (32 * G2LD);
            bf16x8 va[2][2];
#pragma unroll
            for (int nt = 0; nt < 2; ++nt)
#pragma unroll
                for (int ks = 0; ks < 2; ++ks) va[nt][ks] = *(const bf16x8*)(vT_s + (16 * nt + fr) * G2S + 32 * ks + 8 * fq);
            f32x4 o = (f32x4){0.f, 0.f, 0.f, 0.f};
#pragma unroll
            for (int ks = 0; ks < 2; ++ks) {
                const bf16x8 pb = *(const bf16x8*)(P_s + (16 * ct + fr) * G2S + 32 * ks + 8 * fq);
                const bf16x8 vo = *(const bf16x8*)(vT_s + (16 * mo + fr) * G2S + 32 * ks + 8 * fq);
                o = __builtin_amdgcn_mfma_f32_16x16x32_bf16(vo, pb, o, 0, 0, 0);
            }
#pragma unroll
            for (int ks = 0; ks < 4; ++ks) {
                const bf16x8 sa = *(const bf16x8*)(sr + (16 * mo + fr) * G2LD + 32 * ks + 8 * fq);
                const bf16x8 qb = *(const bf16x8*)(q_s + (16 * ct + fr) * G2LD + 32 * ks + 8 * fq);
                o = __builtin_amdgcn_mfma_f32_16x16x32_bf16(sa, qb, o, 0, 0, 0);
            }
            {
                uint2 ov; ov.x = pack2(o[0], o[1]); ov.y = pack2(o[2], o[3]);
                *(uint2*)(O + ((size_t)b * SEQ + n * 64 + 16 * ct + fr) * 1024 + h * 256 + sl * 32 + 16 * mo + 4 * fq) = ov;
            }
            const f32x4 dv = *(const f32x4*)(st + G2_DEC + (16 * wid + 4 * fq) * 4);
            bf16x8 ka[2];
#pragma unroll
            for (int ks = 0; ks < 2; ++ks) ka[ks] = *(const bf16x8*)(kd_s + (16 * wid + fr) * G2S + 32 * ks + 8 * fq);
#pragma unroll
            for (int nt = 0; nt < 2; ++nt) {
                f32x4 a = s[nt] * dv;
#pragma unroll
                for (int ks = 0; ks < 2; ++ks) a = __builtin_amdgcn_mfma_f32_16x16x32_bf16(ka[ks], va[nt][ks], a, 0, 0, 0);
                s[nt] = a;
                uint2 sv; sv.x = pack2(a[0], a[1]); sv.y = pack2(a[2], a[3]);
                *(uint2*)(sw + (16 * nt + fr) * G2LD + 16 * wid + 4 * fq) = sv;
            }
            *(uint4*)(stn + pc0.dst) = ra0;
            *(uint4*)(stn + pc1.dst) = ra1;
            *(uint4*)(stn + pc2.dst) = ra2;
            *(uint4*)(stn + pc3.dst) = ra3;
            *(uint4*)(stn + pc4.dst) = ra4;
            *(uint4*)(stn + pc5.dst) = ra5;
            __syncthreads();
          }
        }
    }
}

__device__ __forceinline__ void phase_gla_g3(const int wv, const Params& p, const bf16_t* O, const bf16_t* OG, bf16_t* ON) {
    const int tid_ = opaque_tid(wv), lane = tid_ & 63, wid = tid_ >> 6;
    const int gw = blockIdx.x * NWAVE + wid, nw = gridDim.x * NWAVE;
    float ng[16];
#pragma unroll
    for (int j = 0; j < 16; ++j) ng[j] = p.gla_norm_g[(lane & 15) * 16 + j];
    constexpr int G3U = 4;
    for (int t0 = gw; t0 < T * REP_G3; t0 += nw * G3U) {
        uint4 ov[G3U][2], gv[G3U][2];
#pragma unroll
        for (int u = 0; u < G3U; ++u) {
            const int t = min(t0 + u * nw, T * REP_G3 - 1) & (T - 1);
            const uint4* orow = (const uint4*)(O + (size_t)t * 1024 + lane * 16);
            const uint4* grow = (const uint4*)(OG + (size_t)t * 1024 + lane * 16);
            ov[u][0] = orow[0]; ov[u][1] = orow[1]; gv[u][0] = grow[0]; gv[u][1] = grow[1];
        }
#pragma unroll
        for (int u = 0; u < G3U; ++u) {
            if (t0 + u * nw >= T * REP_G3) break;
            const int t = (t0 + u * nw) & (T - 1);
            float of[16], gf[16];
#pragma unroll
            for (int q = 0; q < 2; ++q) {
                const unsigned ow[4] = {ov[u][q].x, ov[u][q].y, ov[u][q].z, ov[u][q].w}, gw4[4] = {gv[u][q].x, gv[u][q].y, gv[u][q].z, gv[u][q].w};
#pragma unroll
                for (int k = 0; k < 4; ++k) { of[q * 8 + 2 * k] = bf_lo(ow[k]); of[q * 8 + 2 * k + 1] = bf_hi(ow[k]); gf[q * 8 + 2 * k] = bf_lo(gw4[k]); gf[q * 8 + 2 * k + 1] = bf_hi(gw4[k]); }
            }
            float ss = 0.f;
#pragma unroll
            for (int j = 0; j < 16; ++j) ss += of[j] * of[j];
            ss = dpp_sum16(ss);
            const float rinv = rsqrtf(ss * (1.f / 256.f) + EPS);
            float r[16];
#pragma unroll
            for (int j = 0; j < 16; ++j) r[j] = of[j] * rinv * ng[j] * silu(gf[j]);
            unsigned w[4];
#pragma unroll
            for (int q = 0; q < 4; ++q)
                w[q] = (unsigned)__builtin_amdgcn_cvt_pk_fp8_f32(r[4 * q + 2] * ON8_SCALE, r[4 * q + 3] * ON8_SCALE, __builtin_amdgcn_cvt_pk_fp8_f32(r[4 * q] * ON8_SCALE, r[4 * q + 1] * ON8_SCALE, 0, false), true);
            *(uint4*)((unsigned char*)ON + (size_t)t * 1024 + lane * 16) = make_uint4(w[0], w[1], w[2], w[3]);
        }
    }
}

#define HD __device__ __forceinline__
#define EXPF __expf
#ifndef HD
#define HD __host__ __device__ __forceinline__
#endif
HD unsigned umax_(unsigned a, unsigned b) { return a > b ? a : b; }
HD unsigned umin_(unsigned a, unsigned b) { return a < b ? a : b; }
HD unsigned f2ord(float f) { return __builtin_bit_cast(unsigned, f); }
HD float ord2f(unsigned u) { return __builtin_bit_cast(float, u); }
struct Ce16 { unsigned char i, j; };
constexpr Ce16 OE16[63] = {{0,1}, {2,3}, {0,2}, {1,3}, {1,2}, {4,5}, {6,7}, {4,6}, {5,7}, {5,6}, {0,4}, {2,6}, {2,4}, {1,5}, {3,7}, {3,5}, {1,2}, {3,4}, {5,6}, {8,9}, {10,11}, {8,10}, {9,11}, {9,10},
    {12,13}, {14,15}, {12,14}, {13,15}, {13,14}, {8,12}, {10,14}, {10,12}, {9,13}, {11,15}, {11,13}, {9,10}, {11,12}, {13,14}, {0,8}, {4,12}, {4,8}, {2,10}, {6,14}, {6,10}, {2,4}, {6,8}, {10,12},
    {1,9}, {5,13}, {5,9}, {3,11}, {7,15}, {7,11}, {3,5}, {7,9}, {11,13}, {1,2}, {3,4}, {5,6}, {7,8}, {9,10}, {11,12}, {13,14}};
template <int OFF> HD void sort16_desc(unsigned (&k)[64]) {
#pragma unroll
    for (int c = 0; c < 63; ++c) {
        const unsigned a = k[OFF + OE16[c].i], b = k[OFF + OE16[c].j];
        k[OFF + OE16[c].i] = umax_(a, b); k[OFF + OE16[c].j] = umin_(a, b);
    }
}
HD void merge16(unsigned* a, const unsigned* b) {
#pragma unroll
    for (int i = 0; i < 16; ++i) a[i] = umax_(a[i], b[15 - i]);
#pragma unroll
    for (int stride = 8; stride > 0; stride >>= 1)
#pragma unroll
        for (int i = 0; i < 16; ++i) {
            const int j = i ^ stride;
            if (j > i) { const unsigned x = a[i], y = a[j]; a[i] = umax_(x, y); a[j] = umin_(x, y); }
        }
}
HD void top16_of_64(unsigned (&k)[64]) {
    sort16_desc<0>(k); sort16_desc<16>(k); sort16_desc<32>(k); sort16_desc<48>(k);
    merge16(&k[0], &k[16]); merge16(&k[32], &k[48]); merge16(&k[0], &k[32]);
}
HD void route_select(const unsigned* a1, const unsigned* a2, int* e_out, float* g_out) {
    float v1[16], v2[16];
#pragma unroll
    for (int i = 0; i < 16; ++i) { v1[i] = ord2f(a1[i] & ~127u); v2[i] = ord2f(a2[i] & ~127u); }
    unsigned c[64];
    {
        int cnt = 0;
#pragma unroll
        for (int i = 0; i < 16; ++i)
#pragma unroll
            for (int j = 0; j < 16; ++j)
                if ((i + 1) * (j + 1) <= 16) { c[cnt] = (f2ord(v1[i] + v2[j]) & ~255u) | (unsigned)(i * 16 + j); ++cnt; }
#pragma unroll
        for (int q = 50; q < 64; ++q) c[q] = 0u;
    }
    top16_of_64(c);
    unsigned p1[4], p2[4];
#pragma unroll
    for (int q = 0; q < 4; ++q) {
        p1[q] = (a1[4 * q] & 127u) | ((a1[4 * q + 1] & 127u) << 8) | ((a1[4 * q + 2] & 127u) << 16) | ((a1[4 * q + 3] & 127u) << 24);
        p2[q] = (a2[4 * q] & 127u) | ((a2[4 * q + 1] & 127u) << 8) | ((a2[4 * q + 2] & 127u) << 16) | ((a2[4 * q + 3] & 127u) << 24);
    }
    float cs[16]; float sum = 0.f;
    const float mx = ord2f(c[0] & ~255u);
#pragma unroll
    for (int w = 0; w < 16; ++w) {
        const unsigned code = c[w] & 255u, i = code >> 4, j = code & 15u;
        const unsigned wi = (i >> 2) == 0 ? p1[0] : (i >> 2) == 1 ? p1[1] : (i >> 2) == 2 ? p1[2] : p1[3];
        const unsigned wj = (j >> 2) == 0 ? p2[0] : (j >> 2) == 1 ? p2[1] : (j >> 2) == 2 ? p2[2] : p2[3];
        const unsigned n1 = (wi >> (8 * (i & 3))) & 127u, n2 = (wj >> (8 * (j & 3))) & 127u;
        e_out[w] = (int)(n1 * 128u + n2);
        cs[w] = EXPF(ord2f(c[w] & ~255u) - mx); sum += cs[w];
    }
    const float inv = 1.f / sum;
#pragma unroll
    for (int w = 0; w < 16; ++w) g_out[w] = cs[w] * inv;
}

constexpr int RLD = 136;
__device__ __forceinline__ void route_load_q(bf16x8 (&bq)[8], const bf16_t* QP, size_t tok, int h, int set, int hh) {
#pragma unroll
    for (int ks = 0; ks < 8; ++ks) bq[ks] = *(const bf16x8*)(QP + tok * 2048 + h * 256 + set * 128 + 16 * ks + 8 * hh);
}
__device__ __forceinline__ void route_set_top16(const bf16x8 (&bq)[8], const bf16_t* sk_s, int set, int tl, int hh, unsigned (&out)[16]) {
    unsigned k[64];
#pragma unroll
    for (int nt = 0; nt < 4; ++nt) {
        f32x16 acc;
#pragma unroll
        for (int r = 0; r < 16; ++r) acc[r] = 16.f;
#pragma unroll
        for (int ks = 0; ks < 8; ++ks) {
            const bf16x8 aq = *(const bf16x8*)(sk_s + (set * 128 + 32 * nt + tl) * RLD + 16 * ks + 8 * hh);
            acc = __builtin_amdgcn_mfma_f32_32x32x16_bf16(aq, bq[ks], acc, 0, 0, 0);
        }
#pragma unroll
        for (int r = 0; r < 16; ++r) {
            const unsigned n = 32 * nt + (r & 3) + 8 * (r >> 2) + 4 * hh;
            k[nt * 16 + r] = (f2ord(acc[r]) & ~127u) | n;
        }
        __builtin_amdgcn_sched_barrier(0);
    }
    top16_of_64(k);
    unsigned pk[16];
#pragma unroll
    for (int i = 0; i < 16; ++i) pk[i] = (unsigned)__shfl_xor((int)k[i], 32);
    merge16(k, pk);
#pragma unroll
    for (int i = 0; i < 16; ++i) out[i] = k[i];
}
__device__ __forceinline__ void phase_route(const int wv, const Params& p, char* lds, const bf16_t* QP, int layer, unsigned* RT) {
    const int tid = opaque_tid(wv), lane = tid & 63, wid = tid >> 6, tl = lane & 31, hh = lane >> 5;
    bf16_t* sk_s = (bf16_t*)lds;
    {
        const uint4* src = (const uint4*)(p.ws + OFF_WB + WB_SUBK + (size_t)layer * 2 * 128 * 128 * 2);
        for (int i = tid; i < 2 * 128 * 16; i += NTHR) { const int row = i >> 4, ch = i & 15; *(uint4*)(sk_s + row * RLD + ch * 8) = src[i]; }
    }
    __syncthreads();
    for (int item0 = blockIdx.x; item0 < (T / 256) * 4 * REP_ROUTE; item0 += gridDim.x) {
        const int item = item0 % ((T / 256) * 4);
        const int tile = item >> 2, hp = item & 3;
        const size_t tok = (size_t)tile * 256 + 32 * wid + tl;
        unsigned a1[16], a2[16];
        {
            unsigned b1[16], b2[16];
            bf16x8 qa[8], qb[8];
            route_load_q(qa, QP, tok, 2 * hp, 0, hh);
            route_load_q(qb, QP, tok, 2 * hp, 1, hh);
            __builtin_amdgcn_sched_barrier(0);
            route_set_top16(qa, sk_s, 0, tl, hh, a1);
            __builtin_amdgcn_sched_barrier(0);
            route_load_q(qa, QP, tok, 2 * hp + 1, 0, hh);
            __builtin_amdgcn_sched_barrier(0);
            route_set_top16(qb, sk_s, 1, tl, hh, a2);
            __builtin_amdgcn_sched_barrier(0);
            route_load_q(qb, QP, tok, 2 * hp + 1, 1, hh);
            __builtin_amdgcn_sched_barrier(0);
            route_set_top16(qa, sk_s, 0, tl, hh, b1);
            __builtin_amdgcn_sched_barrier(0);
            route_set_top16(qb, sk_s, 1, tl, hh, b2);
            __builtin_amdgcn_sched_barrier(0);
#pragma unroll
            for (int i = 0; i < 16; ++i) { a1[i] = hh ? b1[i] : a1[i]; a2[i] = hh ? b2[i] : a2[i]; }
        }
        int e[16]; float g[16];
        route_select(a1, a2, e, g);
        const size_t o = (tok * 8 + 2 * hp + hh) * 16;
#pragma unroll
        for (int q = 0; q < 4; ++q) {
            uint4 v;
            v.x = ((unsigned)e[4 * q] << 16) | (pack2(g[4 * q], 0.f) & 0xFFFFu); v.y = ((unsigned)e[4 * q + 1] << 16) | (pack2(g[4 * q + 1], 0.f) & 0xFFFFu);
            v.z = ((unsigned)e[4 * q + 2] << 16) | (pack2(g[4 * q + 2], 0.f) & 0xFFFFu); v.w = ((unsigned)e[4 * q + 3] << 16) | (pack2(g[4 * q + 3], 0.f) & 0xFFFFu);
            *(uint4*)(RT + o + 4 * q) = v;
        }
    }
}

HD void s128_inreg(unsigned (&k)[8], int li, int size, int stride) {
#pragma unroll
    for (int r = 0; r < 8; ++r) {
        const int r2 = r ^ stride;
        if (r2 > r) {
            const int i = li * 8 + r;
            const bool asc = ((i & size) == 0);
            const unsigned a = k[r], b = k[r2];
            const unsigned lo = umin_(a, b), hi = umax_(a, b);
            k[r] = asc ? lo : hi; k[r2] = asc ? hi : lo;
        }
    }
}
HD void s128_xlane(unsigned (&k)[8], const unsigned (&pk)[8], int li, int size, int m) {
    const bool lower = ((li & m) == 0);
    const bool asc = (((li * 8) & size) == 0);
    const bool keepmin = (lower == asc);
#pragma unroll
    for (int r = 0; r < 8; ++r) k[r] = keepmin ? umin_(k[r], pk[r]) : umax_(k[r], pk[r]);
}

__device__ __forceinline__ void s128_xstage(unsigned (&k)[8], int li, int size, int m) {
    unsigned pk[8];
#pragma unroll
    for (int r = 0; r < 8; ++r) pk[r] = (unsigned)__shfl_xor((int)k[r], m);
    s128_xlane(k, pk, li, size, m);
}
typedef float f32x2 __attribute__((ext_vector_type(2)));
typedef _Float16 h16x2 __attribute__((ext_vector_type(2)));
struct Row4 { uint4 c[4]; };
struct RowV { uint4 c[2]; };
__device__ __forceinline__ RowV peer_load_rowv1k(const unsigned char* tab, unsigned e, int li) {
    RowV r; const unsigned char* row = tab + (size_t)e * 1024 + li * 16;
    r.c[0] = *(const uint4*)(row); r.c[1] = *(const uint4*)(row + 256);
    return r;
}
__device__ __forceinline__ void peer_vgroup(const RowV& r0, const RowV& r1, const RowV& r2, const RowV& r3, int w4, int (&acc)[32]) {
#pragma unroll
    for (int c2 = 0; c2 < 2; ++c2) {
        const unsigned a[4] = {r0.c[c2].x, r0.c[c2].y, r0.c[c2].z, r0.c[c2].w}, b[4] = {r1.c[c2].x, r1.c[c2].y, r1.c[c2].z, r1.c[c2].w};
        const unsigned c[4] = {r2.c[c2].x, r2.c[c2].y, r2.c[c2].z, r2.c[c2].w}, d[4] = {r3.c[c2].x, r3.c[c2].y, r3.c[c2].z, r3.c[c2].w};
#pragma unroll
        for (int q = 0; q < 4; ++q) {
            const unsigned t0 = __builtin_amdgcn_perm(b[q], a[q], 0x05010400u), t1 = __builtin_amdgcn_perm(b[q], a[q], 0x07030602u);
            const unsigned t2 = __builtin_amdgcn_perm(d[q], c[q], 0x05010400u), t3 = __builtin_amdgcn_perm(d[q], c[q], 0x07030602u);
            const unsigned o0 = __builtin_amdgcn_perm(t2, t0, 0x05040100u), o1 = __builtin_amdgcn_perm(t2, t0, 0x07060302u);
            const unsigned o2 = __builtin_amdgcn_perm(t3, t1, 0x05040100u), o3 = __builtin_amdgcn_perm(t3, t1, 0x07060302u);
            const int k = (c2 * 4 + q) * 4;
            acc[k + 0] = __builtin_amdgcn_sdot4((int)o0, w4, acc[k + 0], false); acc[k + 1] = __builtin_amdgcn_sdot4((int)o1, w4, acc[k + 1], false);
            acc[k + 2] = __builtin_amdgcn_sdot4((int)o2, w4, acc[k + 2], false); acc[k + 3] = __builtin_amdgcn_sdot4((int)o3, w4, acc[k + 3], false);
        }
    }
}
__device__ __forceinline__ RowV peer_load_rowv(const unsigned char* tab, unsigned e, int li) {
    RowV r; const unsigned char* row = tab + (size_t)e * 512 + li * 16;
    r.c[0] = *(const uint4*)(row); r.c[1] = *(const uint4*)(row + 256);
    return r;
}
#ifndef PEER_RING
#define PEER_RING 4
#endif
#ifndef PEER_RING_U
#define PEER_RING_U 8
#endif
__device__ __forceinline__ Row4 peer_load_row(const unsigned char* tab, unsigned e, int li) {
    Row4 r; const unsigned char* row = tab + (size_t)e * 1024 + li * 16;
#pragma unroll
    for (int c = 0; c < 4; ++c) r.c[c] = *(const uint4*)(row + c * 256);
    return r;
}
template <int MODE, bool PROBE = false>
__device__ __forceinline__ void phase_peer(const int wv, const Params& p, char* lds, int layer, const bf16_t* H2, const bf16_t* XIN, const unsigned* RT,
                                           const float* g2, bf16_t* XOUT, bf16_t* HKV, bf16_t* HQ) {
    const int tid = opaque_tid(wv), lane0 = tid & 63, wid = tid >> 6;
    const int gw = blockIdx.x * NWAVE + wid, nw = gridDim.x * NWAVE;
    const unsigned char* U = (const unsigned char*)(p.ws + OFF_TBU) + (size_t)layer * NEXP * 512;
    const unsigned char* V = (const unsigned char*)(p.ws + OFF_TBV) + (size_t)layer * NEXP * 1024;
    const float* modv = (const float*)(p.ws + OFF_MOD);
    const float* kvmod = modv + 2 * 8 * 6144;
    const int peer_total = (T / 4) * REP_PEER, peer_rounds = (peer_total + nw - 1) / nw;
#define PEER_BARRIER() do { asm volatile("s_waitcnt lgkmcnt(0)" ::: "memory"); __builtin_amdgcn_s_barrier(); asm volatile("" ::: "memory"); } while (0)
#define PEER_PREFETCH(tt_, li_) do { const unsigned* rp_ = RT + (size_t)(tt_) * 128 + (li_) * 8; nk0 = *(const uint4*)rp_; nk1 = *(const uint4*)(rp_ + 4); \
        const bf16_t* hp_ = H2 + (size_t)(tt_) * 1024 + (li_) * 32; nh0 = *(const uint4*)hp_; nh1 = *(const uint4*)(hp_ + 8); nh2 = *(const uint4*)(hp_ + 16); nh3 = *(const uint4*)(hp_ + 24); \
        nh4 = *(const uint4*)(hp_ + 512); nh5 = *(const uint4*)(hp_ + 520); nh6 = *(const uint4*)(hp_ + 528); nh7 = *(const uint4*)(hp_ + 536); } while (0)
    uint4 nk0, nk1, nh0, nh1, nh2, nh3, nh4, nh5, nh6, nh7;
    { const int tb_ = min(gw, peer_total - 1) & (T / 4 - 1); PEER_PREFETCH(tb_ * 4 + (lane0 >> 4), lane0 & 15); }
    for (int rnd = 0; rnd < peer_rounds; ++rnd) {
        const int tb0 = min(gw + rnd * nw, peer_total - 1);
        const int tb = tb0 & (T / 4 - 1);
        int lane = lane0; asm volatile("" : "+v"(lane));
        const int grp = lane >> 4, li = lane & 15;
        const int t = tb * 4 + grp, b = t >> 13;
        const uint4 ck0 = nk0, ck1 = nk1, ch0 = nh0, ch1 = nh1, ch2 = nh2, ch3 = nh3, ch4 = nh4, ch5 = nh5, ch6 = nh6, ch7 = nh7;
        { const int tbn = min(gw + min(rnd + 1, peer_rounds - 1) * nw, peer_total - 1) & (T / 4 - 1); PEER_PREFETCH(tbn * 4 + grp, li); }
        unsigned kk[8];
        {
            const uint4 k0 = ck0, k1 = ck1;
            kk[0] = k0.x; kk[1] = k0.y; kk[2] = k0.z; kk[3] = k0.w; kk[4] = k1.x; kk[5] = k1.y; kk[6] = k1.z; kk[7] = k1.w;
            if (PROBE) {
#pragma unroll
                for (int r = 0; r < 8; ++r) kk[r] &= 0x00FFFFFFu;
            }
            s128_inreg(kk, li, 2, 1);
            s128_inreg(kk, li, 4, 2);
            s128_inreg(kk, li, 4, 1);
            s128_inreg(kk, li, 8, 4);
            s128_inreg(kk, li, 8, 2);
            s128_inreg(kk, li, 8, 1);
            s128_xstage(kk, li, 16, 1);
            s128_inreg(kk, li, 16, 4);
            s128_inreg(kk, li, 16, 2);
            s128_inreg(kk, li, 16, 1);
            s128_xstage(kk, li, 32, 2);
            s128_xstage(kk, li, 32, 1);
            s128_inreg(kk, li, 32, 4);
            s128_inreg(kk, li, 32, 2);
            s128_inreg(kk, li, 32, 1);
            s128_xstage(kk, li, 64, 4);
            s128_xstage(kk, li, 64, 2);
            s128_xstage(kk, li, 64, 1);
            s128_inreg(kk, li, 64, 4);
            s128_inreg(kk, li, 64, 2);
            s128_inreg(kk, li, 64, 1);
            s128_xstage(kk, li, 128, 8);
            s128_xstage(kk, li, 128, 4);
            s128_xstage(kk, li, 128, 2);
            s128_xstage(kk, li, 128, 1);
            s128_inreg(kk, li, 128, 4);
            s128_inreg(kk, li, 128, 2);
            s128_inreg(kk, li, 128, 1);
        }
        unsigned* pick_s = (unsigned*)lds + (wid * 4 + grp) * 256;
        float* aw_s = (float*)(pick_s + 128);
        *(uint4*)(pick_s + li * 8) = make_uint4(kk[0], kk[1], kk[2], kk[3]);
        *(uint4*)(pick_s + li * 8 + 4) = make_uint4(kk[4], kk[5], kk[6], kk[7]);
        PEER_BARRIER();
        {
            int hH[8], hL[8]; float inv_scale;
            RowV R[PEER_RING_U];
#pragma unroll
            for (int j = 0; j < PEER_RING_U - 1; ++j) R[j] = peer_load_rowv(U, pick_s[j] >> 16, li);
            {
                float hf[64]; float amax = 0.f;
                const uint4 hrow[8] = {ch0, ch1, ch2, ch3, ch4, ch5, ch6, ch7};
#pragma unroll
                for (int c = 0; c < 2; ++c)
#pragma unroll
                    for (int q = 0; q < 4; ++q) {
                        const uint4 h0 = hrow[c * 4 + q];
                        const unsigned w[4] = {h0.x, h0.y, h0.z, h0.w};
#pragma unroll
                        for (int k = 0; k < 4; ++k) { hf[c * 32 + 8 * q + 2 * k] = bf_lo(w[k]); hf[c * 32 + 8 * q + 2 * k + 1] = bf_hi(w[k]); }
                    }
#pragma unroll
                for (int q = 0; q < 64; ++q) amax = fmaxf(amax, fabsf(hf[q]));
                amax = fmaxf(dpp_max16(amax), 1e-20f);
                const float sh = 119.f / amax;
                inv_scale = amax * (1.f / (119.f * TBU_SCALE));
#pragma unroll
                for (int d = 0; d < 8; ++d) {
                    unsigned wH = 0u, wL = 0u;
#pragma unroll
                    for (int k = 0; k < 8; ++k) {
                        const int h8 = __float2int_rn(hf[8 * d + k] * sh);
                        const int hh = (h8 + 8) >> 4;
                        const int hl = h8 - 16 * hh;
                        wH |= ((unsigned)hh & 15u) << (4 * k); wL |= ((unsigned)hl & 15u) << (4 * k);
                    }
                    hH[d] = (int)wH; hL[d] = (int)wL;
                }
            }
#pragma unroll 1
            for (int s0 = 0; s0 < 128; s0 += PEER_RING_U) {
#pragma unroll
                for (int j = 0; j < PEER_RING_U; ++j) {
                    const int s = s0 + j;
                    if (s + PEER_RING_U - 1 < 128) R[(j + PEER_RING_U - 1) % PEER_RING_U] = peer_load_rowv(U, pick_s[s + PEER_RING_U - 1] >> 16, li);
                    int accH = 0, accL = 0;
#pragma unroll
                    for (int c = 0; c < 2; ++c) {
                        const int uw[4] = {(int)R[j].c[c].x, (int)R[j].c[c].y, (int)R[j].c[c].z, (int)R[j].c[c].w};
#pragma unroll
                        for (int q = 0; q < 4; ++q) {
                            accH = __builtin_amdgcn_sdot8(uw[q], hH[c * 4 + q], accH, false);
                            accL = __builtin_amdgcn_sdot8(uw[q], hL[c * 4 + q], accL, false);
                        }
                    }
                    const float a = dpp_sum16((float)(16 * accH + accL)) * inv_scale;
                    if (li == 0) aw_s[s] = a;
                }
            }
        }
        RowV A0 = peer_load_rowv1k(V, pick_s[0] >> 16, li), A1 = peer_load_rowv1k(V, pick_s[1] >> 16, li), A2 = peer_load_rowv1k(V, pick_s[2] >> 16, li), A3 = peer_load_rowv1k(V, pick_s[3] >> 16, li);
        float wscale;
        {
            const float4 a0 = *(const float4*)(aw_s + li * 8), a1 = *(const float4*)(aw_s + li * 8 + 4);
            const float av[8] = {a0.x, a0.y, a0.z, a0.w, a1.x, a1.y, a1.z, a1.w};
            float wv[8]; float wmax = 0.f;
#pragma unroll
            for (int r = 0; r < 8; ++r) {
                const float a = av[r];
                wv[r] = __uint_as_float(kk[r] << 16) * 0.5f * a * (1.f + erff(a * 0.7071067811865476f));
                wmax = fmaxf(wmax, fabsf(wv[r]));
            }
            wmax = fmaxf(dpp_max16(wmax), 1e-30f);
            const float ws = 127.f / wmax;
            wscale = wmax * (1.f / (127.f * TBV_SCALE));
            int* iw_s = (int*)aw_s;
            const unsigned w_lo = q8(wv[0] * ws) | (q8(wv[1] * ws) << 8) | (q8(wv[2] * ws) << 16) | (q8(wv[3] * ws) << 24);
            const unsigned w_hi = q8(wv[4] * ws) | (q8(wv[5] * ws) << 8) | (q8(wv[6] * ws) << 16) | (q8(wv[7] * ws) << 24);
            __builtin_amdgcn_s_waitcnt(0xc07f);
            *(uint2*)(iw_s + 2 * li) = make_uint2(w_lo, w_hi);
        }
        PEER_BARRIER();
        float y[64];
        uint2 xu[16];
        {
            const int* iw_s = (const int*)aw_s;
#pragma unroll
            for (int hs = 0; hs < 2; ++hs) {
                const unsigned char* Vh = V + hs * 512;
                if (hs == 1) {
#pragma unroll
                    for (int cq = 0; cq < 16; ++cq) xu[cq] = *(const uint2*)(XIN + (size_t)t * D + 256 * (cq >> 2) + 4 * li + 64 * (cq & 3));
                }
                int acc[32];
#pragma unroll
                for (int q = 0; q < 32; ++q) acc[q] = 0;
#pragma unroll 1
                for (int j2 = 0; j2 < 32; j2 += 2) {
                    const int p1 = 4 * (j2 + 1);
                    const RowV B0 = peer_load_rowv1k(Vh, pick_s[p1] >> 16, li), B1 = peer_load_rowv1k(Vh, pick_s[p1 + 1] >> 16, li), B2 = peer_load_rowv1k(Vh, pick_s[p1 + 2] >> 16, li), B3 = peer_load_rowv1k(Vh, pick_s[p1 + 3] >> 16, li);
                    peer_vgroup(A0, A1, A2, A3, iw_s[j2], acc);
                    const int p2 = 4 * ((j2 + 2) & 31);
                    const unsigned char* Vn = (j2 + 2 < 32) ? Vh : V + 512;
                    A0 = peer_load_rowv1k(Vn, pick_s[p2] >> 16, li); A1 = peer_load_rowv1k(Vn, pick_s[p2 + 1] >> 16, li); A2 = peer_load_rowv1k(Vn, pick_s[p2 + 2] >> 16, li); A3 = peer_load_rowv1k(Vn, pick_s[p2 + 3] >> 16, li);
                    peer_vgroup(B0, B1, B2, B3, iw_s[j2 + 1], acc);
                }
#pragma unroll
                for (int q = 0; q < 32; ++q) y[hs * 32 + q] = (float)acc[q] * wscale;
            }
        }
        float ss = 0.f;
        {
            float4 ga[16];
#pragma unroll
            for (int c = 0; c < 4; ++c)
#pragma unroll
                for (int q4 = 0; q4 < 4; ++q4) {
                    const int eo = 256 * c + 4 * li + 64 * q4;
                    ga[c * 4 + q4] = *(const float4*)(g2 + (size_t)b * 6144 + eo);
                }
#pragma unroll
            for (int cq = 0; cq < 16; ++cq) {
                const float4 xa = make_float4(bf_lo(xu[cq].x), bf_hi(xu[cq].x), bf_lo(xu[cq].y), bf_hi(xu[cq].y));
                const int yi = 4 * cq;
                y[yi + 0] = xa.x + ga[cq].x * y[yi + 0]; y[yi + 1] = xa.y + ga[cq].y * y[yi + 1]; y[yi + 2] = xa.z + ga[cq].z * y[yi + 2]; y[yi + 3] = xa.w + ga[cq].w * y[yi + 3];
                ss = fmaf(y[yi + 0], y[yi + 0], ss); ss = fmaf(y[yi + 1], y[yi + 1], ss); ss = fmaf(y[yi + 2], y[yi + 2], ss); ss = fmaf(y[yi + 3], y[yi + 3], ss);
            }
        }
        ss = dpp_sum16(ss);
        const float rinv = rsqrtf(ss * (1.f / D) + EPS);
#pragma unroll
        for (int c = 0; c < 4; ++c) {
            const int off = 256 * c + 4 * li;
            if (MODE == 0) {
#pragma unroll
                for (int q4 = 0; q4 < 4; ++q4) {
                    const float yy[4] = {y[c * 16 + 4 * q4 + 0], y[c * 16 + 4 * q4 + 1], y[c * 16 + 4 * q4 + 2], y[c * 16 + 4 * q4 + 3]};
                    if (!PROBE) { uint2 xo; xo.x = pack2(yy[0], yy[1]); xo.y = pack2(yy[2], yy[3]); *(uint2*)(XOUT + (size_t)t * D + off + 64 * q4) = xo; }
                    const bf16_t* cmb = (const bf16_t*)(p.ws + OFF_CMB) + (size_t)b * 4096 + off + 64 * q4;
                    const uint2 ka = *(const uint2*)cmb, kb = *(const uint2*)(cmb + 1024), qa = *(const uint2*)(cmb + 2048), qb = *(const uint2*)(cmb + 3072);
                    const float xn0 = yy[0] * rinv, xn1 = yy[1] * rinv, xn2 = yy[2] * rinv, xn3 = yy[3] * rinv;
                    const float k0 = xn0 * bf_lo(ka.x) + bf_lo(kb.x), k1 = xn1 * bf_hi(ka.x) + bf_hi(kb.x), k2 = xn2 * bf_lo(ka.y) + bf_lo(kb.y), k3 = xn3 * bf_hi(ka.y) + bf_hi(kb.y);
                    const float q0 = xn0 * bf_lo(qa.x) + bf_lo(qb.x), q1 = xn1 * bf_hi(qa.x) + bf_hi(qb.x), q2 = xn2 * bf_lo(qa.y) + bf_lo(qb.y), q3 = xn3 * bf_hi(qa.y) + bf_hi(qb.y);
                    const unsigned o1 = (unsigned)__builtin_amdgcn_cvt_pk_fp8_f32(k2 * H8_SCALE, k3 * H8_SCALE, __builtin_amdgcn_cvt_pk_fp8_f32(k0 * H8_SCALE, k1 * H8_SCALE, 0, false), true);
                    const unsigned o2 = (unsigned)__builtin_amdgcn_cvt_pk_fp8_f32(q2 * H8_SCALE, q3 * H8_SCALE, __builtin_amdgcn_cvt_pk_fp8_f32(q0 * H8_SCALE, q1 * H8_SCALE, 0, false), true);
                    if (!PROBE) { *(unsigned*)((unsigned char*)HKV + (size_t)t * D + off + 64 * q4) = o1; *(unsigned*)((unsigned char*)HQ + (size_t)t * D + off + 64 * q4) = o2; }
                    else asm volatile("" :: "v"(o1), "v"(o2));
                }
                __builtin_amdgcn_sched_barrier(0);
            } else {
#pragma unroll
                for (int q4 = 0; q4 < 4; ++q4) {
                    const float yy[4] = {y[c * 16 + 4 * q4 + 0], y[c * 16 + 4 * q4 + 1], y[c * 16 + 4 * q4 + 2], y[c * 16 + 4 * q4 + 3]};
                    const float4 fg = *(const float4*)(p.final_norm_g + off + 64 * q4);
                    if (!PROBE) *(float4*)(p.out + (size_t)t * D + off + 64 * q4) = make_float4(yy[0] * rinv * fg.x, yy[1] * rinv * fg.y, yy[2] * rinv * fg.z, yy[3] * rinv * fg.w);
                    else asm volatile("" :: "v"(yy[0] * rinv * fg.x), "v"(yy[1] * rinv * fg.y), "v"(yy[2] * rinv * fg.z), "v"(yy[3] * rinv * fg.w));
                }
            }
        }
    }
}

constexpr int AKLD = 72, AVLD = 264;
__device__ __forceinline__ void phase_swa(const int wv, const Params& p, char* lds, const bf16_t* QA, const bf16_t* KSH, const bf16_t* VTSH, bf16_t* OA) {
    const int tid = opaque_tid(wv), lane = tid & 63, wid = tid >> 6, ql = lane & 31, hh = lane >> 5;
    const int qs = wid & 3, hp = wid >> 2;
    bf16_t* K_s = (bf16_t*)lds;
    bf16_t* V_s = K_s + 256 * AKLD;
    for (int item0 = blockIdx.x; item0 < NB * 64 * 4 * REP_SWA; item0 += gridDim.x) {
        const int item = item0 % (NB * 64 * 4);
        const int kvh = item & 3, n = (item >> 2) & 63, b = item >> 8;
        __syncthreads();
#pragma unroll
        for (int i = 0; i < 4; ++i) {
            const int idx = tid + NTHR * i, row = idx >> 3, ch = idx & 7;
            uint4 v = make_uint4(0u, 0u, 0u, 0u);
            if (n > 0 || row >= 128) v = *(const uint4*)(KSH + ((size_t)b * SEQ + 128 * n - 128 + row) * 256 + kvh * 64 + ch * 8);
            *(uint4*)(K_s + row * AKLD + ch * 8) = v;
        }
#pragma unroll
        for (int i = 0; i < 4; ++i) {
            const int idx = tid + NTHR * i, row = idx >> 5, ch = idx & 31;
            uint4 v = make_uint4(0u, 0u, 0u, 0u);
            if (n > 0 || ch >= 16) v = *(const uint4*)(VTSH + ((size_t)b * 256 + kvh * 64 + row) * SEQ + 128 * n - 128 + ch * 8);
            *(uint4*)(V_s + row * AVLD + ch * 8) = v;
        }
        __syncthreads();
        const size_t tq = (size_t)b * SEQ + 128 * n + 32 * qs + ql;
#pragma unroll 1
        for (int gi = 0; gi < 2; ++gi) {
            const int head = kvh * 4 + hp * 2 + gi;
            const float sink = p.swa_sinks[head];
            bf16x8 bq[4];
#pragma unroll
            for (int ks = 0; ks < 4; ++ks) bq[ks] = *(const bf16x8*)(QA + tq * 1024 + head * 64 + 16 * ks + 8 * hh);
            f32x16 sc[5];
#pragma unroll
            for (int kt = 0; kt < 5; ++kt) {
#pragma unroll
                for (int r = 0; r < 16; ++r) sc[kt][r] = 0.f;
                const int m0 = 32 * (qs + kt);
#pragma unroll
                for (int ks = 0; ks < 4; ++ks) {
                    const bf16x8 ka = *(const bf16x8*)(K_s + (m0 + ql) * AKLD + 16 * ks + 8 * hh);
                    sc[kt] = __builtin_amdgcn_mfma_f32_32x32x16_bf16(ka, bq[ks], sc[kt], 0, 0, 0);
                }
                __builtin_amdgcn_sched_barrier(0);
            }
            float mx = -1e30f;
#pragma unroll
            for (int kt = 0; kt < 5; ++kt) {
                const bool tile_dead = (n == 0) && (qs + kt < 4);
#pragma unroll
                for (int r = 0; r < 16; ++r) {
                    const int rr = (r & 3) + 8 * (r >> 2) + 4 * hh;
                    bool valid = !tile_dead;
                    if (kt == 0) valid = valid && (rr > ql);
                    if (kt == 4) valid = valid && (rr <= ql);
                    const float s = valid ? sc[kt][r] : -1e30f;
                    sc[kt][r] = s; mx = fmaxf(mx, s);
                }
            }
            mx = fmaxf(mx, __shfl_xor(mx, 32));
            mx = fmaxf(mx, sink);
            float lsum = 0.f;
#pragma unroll
            for (int kt = 0; kt < 5; ++kt)
#pragma unroll
                for (int r = 0; r < 16; ++r) { const float pv = __expf(sc[kt][r] - mx); sc[kt][r] = pv; lsum += pv; }
            lsum += __shfl_xor(lsum, 32);
            const float inv = 1.f / (lsum + __expf(sink - mx));
            f32x16 oacc[2];
#pragma unroll
            for (int dt = 0; dt < 2; ++dt)
#pragma unroll
                for (int r = 0; r < 16; ++r) oacc[dt][r] = 0.f;
#pragma unroll
            for (int kt = 0; kt < 5; ++kt) {
                const int m0 = 32 * (qs + kt);
#pragma unroll
                for (int s = 0; s < 2; ++s) {
                    union { bf16x8 v; unsigned u[4]; } pf;
#pragma unroll
                    for (int j = 0; j < 4; ++j) pf.u[j] = pack2(sc[kt][8 * s + 2 * j], sc[kt][8 * s + 2 * j + 1]);
#pragma unroll
                    for (int dt = 0; dt < 2; ++dt) {
                        const bf16_t* vp = V_s + (32 * dt + ql) * AVLD + m0 + 16 * s + 4 * hh;
                        union { bf16x8 v; uint2 u[2]; } vf;
                        vf.u[0] = *(const uint2*)vp; vf.u[1] = *(const uint2*)(vp + 8);
                        oacc[dt] = __builtin_amdgcn_mfma_f32_32x32x16_bf16(vf.v, pf.v, oacc[dt], 0, 0, 0);
                    }
                    __builtin_amdgcn_sched_barrier(0);
                }
            }
            {
                const float is = inv * O8_SCALE;
                unsigned pc[2][4];
#pragma unroll
                for (int dt = 0; dt < 2; ++dt)
#pragma unroll
                    for (int g4 = 0; g4 < 4; ++g4)
                        pc[dt][g4] = (unsigned)__builtin_amdgcn_cvt_pk_fp8_f32(oacc[dt][4 * g4 + 2] * is, oacc[dt][4 * g4 + 3] * is, __builtin_amdgcn_cvt_pk_fp8_f32(oacc[dt][4 * g4] * is, oacc[dt][4 * g4 + 1] * is, 0, false), true);
#pragma unroll
                for (int g4 = 0; g4 < 4; ++g4) { const u32x2 r = __builtin_amdgcn_permlane32_swap(pc[0][g4], pc[1][g4], false, false); pc[0][g4] = r.x; pc[1][g4] = r.y; }
                unsigned char* op = (unsigned char*)OA + tq * 1024 + head * 64 + 32 * hh;
                *(uint4*)op = make_uint4(pc[0][0], pc[1][0], pc[0][1], pc[1][1]);
                *(uint4*)(op + 16) = make_uint4(pc[0][2], pc[1][2], pc[0][3], pc[1][3]);
            }
        }
    }
}

__global__ void __launch_bounds__(NTHR, 2) yoco_megakernel(Params p) {
    __shared__ __attribute__((aligned(16))) char lds[LDS_BYTES];
    cg::grid_group grid = cg::this_grid();
    int wv = __builtin_amdgcn_readfirstlane((int)threadIdx.x >> 6); asm volatile("" : "+s"(wv));
    volatile LAS unsigned* xb_words = (volatile LAS unsigned*)(lds + LDS_BYTES - 16);
    if (threadIdx.x == 0) { xb_words[0] = 0u; xb_words[1] = 0u; }
    __syncthreads();
    const XcdBarrier xb = xcd_barrier_post((unsigned*)p.ws, xb_words);
    float* modv = (float*)(p.ws + OFF_MOD);
    bf16_t* R0 = (bf16_t*)(p.ws + OFF_R0);
    bf16_t* X2 = R0 + (size_t)T * D;
    bf16_t* A0 = (bf16_t*)(p.ws + OFF_A0); bf16_t* A1 = (bf16_t*)(p.ws + OFF_A1); bf16_t* A2 = (bf16_t*)(p.ws + OFF_A2); bf16_t* A3 = (bf16_t*)(p.ws + OFF_A3);
    const bf16_t* WB = (const bf16_t*)(p.ws + OFF_WB);
    bf16_t* OBUF = (bf16_t*)p.out;
    bf16_t* PM = (bf16_t*)((char*)p.out + 128 * MiB);
    float* GL = (float*)((char*)p.out + 160 * MiB);
    float* DEC = (float*)((char*)p.out + 164 * MiB);
    unsigned* RT = (unsigned*)(p.ws + OFF_RTE);
    phase_prep(wv, p, lds);
    grid.sync();
    if (blockIdx.x < NB) {
        const int b = blockIdx.x; const float* kvmod = modv + 2 * 8 * 6144; bf16_t* cmb = (bf16_t*)(p.ws + OFF_CMB) + (size_t)b * 4096;
        for (int d = opaque_tid(wv); d < 1024; d += NTHR) {
            const float kvA = p.kv_norm_g[d] * (1.f + kvmod[b * 2048 + 1024 + d]), kvB = kvmod[b * 2048 + d];
            const float qA = p.norm_g[2 * 1024 + d] * (1.f + modv[(8 + b) * 6144 + 1024 + d]), qB = modv[(8 + b) * 6144 + d];
            cmb[d] = (bf16_t)(pack2(kvA, 0.f) & 0xFFFFu); cmb[1024 + d] = (bf16_t)(pack2(kvB, 0.f) & 0xFFFFu);
            cmb[2048 + d] = (bf16_t)(pack2(qA, 0.f) & 0xFFFFu); cmb[3072 + d] = (bf16_t)(pack2(qB, 0.f) & 0xFFFFu);
        }
    }
    phase_modulate<false>(wv, p.x, p.norm_g, modv + 0, modv + 1024, 6144, A0);
    xcd_barrier(xb);
    run_gemm(wv, lds, A0, WB + WB_MAIN / 2, T, 2304, EpiInMain{A1, A1 + (size_t)T * 512, A3, GL});
    run_gemm(wv, lds, WB + WB_V / 2, A0, 1024, T, EpiVT{A2, 1024, 1.f});
    xcd_barrier(xb);
    phase_gla_g1(wv, p, lds, GL, PM, DEC);
    xcd_barrier(xb);
    phase_gla_g2(wv, p, lds, PM, DEC, OBUF);
    xcd_barrier(xb);
    phase_gla_g3(wv, p, OBUF, A3, A2);
    xcd_barrier(xb);
    run_gemm8(wv, lds, (const unsigned char*)A2, (const unsigned char*)(p.ws + OFF_WB) + WB_WOUT, T, 1024, EpiResid<false>{p.x, modv + 2048, 6144, R0, 1.f / (ON8_SCALE * PWQ8_SCALE)});
    xcd_barrier(xb);
    phase_modulate<true>(wv, R0, p.norm_g + 1024, modv + 3072, modv + 4096, 6144, A0);
    xcd_barrier(xb);
    run_gemm(wv, lds, A0, WB + WB_PWQ / 2, T, 2048, EpiRowBf16{A1, 2048});
    xcd_barrier(xb);
    phase_route(wv, p, lds, A1, 0, RT);
    xcd_barrier(xb);
#ifdef PROBE_PEER
    phase_peer<0, true>(wv, p, lds, 0, A0, R0, RT, modv + 5 * 1024, X2, A1, A2);
#endif
    phase_peer<0>(wv, p, lds, 0, A0, R0, RT, modv + 5 * 1024, X2, A1, A2);
    xcd_barrier(xb);
    bf16_t* KSH = A0; bf16_t* VTSH = A0 + (size_t)T * 256;
    {
        const unsigned char* W8 = (const unsigned char*)(p.ws + OFF_WB);
        constexpr float SC = 1.f / (H8_SCALE * PWQ8_SCALE);
        run_gemm8(wv, lds, (const unsigned char*)A1, W8 + WB_KVK, T, 256, EpiRopeBf16{KSH, 256, SC, (const float*)(p.ws + OFF_ROPE)});
        run_gemm8(wv, lds, W8 + WB_KVV, (const unsigned char*)A1, 256, T, EpiVT{VTSH, 256, SC});
        run_gemm8(wv, lds, (const unsigned char*)A2, W8 + WB_SWAQ, T, 1024, EpiRopeBf16{A3, 1024, 0.125f * SC, (const float*)(p.ws + OFF_ROPE)});
    }
    xcd_barrier(xb);
    phase_swa(wv, p, lds, A3, KSH, VTSH, A1);
    xcd_barrier(xb);
    run_gemm8(wv, lds, (const unsigned char*)A1, (const unsigned char*)(p.ws + OFF_WB + WB_SWAO), T, 1024, EpiResid<true>{X2, modv + 8 * 6144 + 2048, 6144, R0, 1.f / (O8_SCALE * PWQ8_SCALE)});
    xcd_barrier(xb);
    phase_modulate<true>(wv, R0, p.norm_g + 3 * 1024, modv + 8 * 6144 + 3072, modv + 8 * 6144 + 4096, 6144, A0, (unsigned char*)A3);
    xcd_barrier(xb);
    run_gemm8(wv, lds, (const unsigned char*)A3, (const unsigned char*)(p.ws + OFF_WB) + WB_PWQ + 2048ull * 2048, T, 2048, EpiRowBf16S{A1, 2048, 1.f / (H8_SCALE * PWQ8_SCALE)});
    xcd_barrier(xb);
    phase_route(wv, p, lds, A1, 1, RT);
    xcd_barrier(xb);
#ifdef PROBE_PEER
    phase_peer<1, true>(wv, p, lds, 1, A0, R0, RT, modv + 8 * 6144 + 5 * 1024, nullptr, nullptr, nullptr);
#endif
    phase_peer<1>(wv, p, lds, 1, A0, R0, RT, modv + 8 * 6144 + 5 * 1024, nullptr, nullptr, nullptr);
}

extern "C" void kernel_launch(void* const* d_in, const int* in_sizes, int n_in, void* d_out, int out_size, void* d_ws, size_t ws_size,
                              hipStream_t stream) {
    if (ws_size < WS_NEED) { fprintf(stderr, "workspace too small: %zu < %zu\n", ws_size, (size_t)WS_NEED); return; }
    Params p{};
    p.x = (const float*)d_in[0]; p.c = (const float*)d_in[1]; p.pos = (const int*)d_in[2]; p.mod_w = (const float*)d_in[3];
    p.mod_b = (const float*)d_in[4]; p.norm_g = (const float*)d_in[5]; p.gla_w_in = (const float*)d_in[6]; p.gla_w_g2 = (const float*)d_in[7];
    p.gla_b_g2 = (const float*)d_in[8]; p.gla_norm_g = (const float*)d_in[9]; p.gla_w_out = (const float*)d_in[10];
    p.kv_mod_w = (const float*)d_in[11]; p.kv_mod_b = (const float*)d_in[12]; p.kv_norm_g = (const float*)d_in[13]; p.kv_w = (const float*)d_in[14];
    p.swa_w_q = (const float*)d_in[15]; p.swa_sinks = (const float*)d_in[16]; p.swa_w_out = (const float*)d_in[17];
    p.peer_w_q = (const float*)d_in[18]; p.peer_subkeys = (const float*)d_in[19]; p.peer_u = (const float*)d_in[20]; p.peer_v = (const float*)d_in[21];
    p.final_norm_g = (const float*)d_in[22];
    p.out = (float*)d_out; p.ws = (char*)d_ws;
    static int grid_blocks = 0;
    if (!grid_blocks) {
        int dev = 0, cus = 0, per_cu = 0;
        (void)hipGetDevice(&dev);
        (void)hipDeviceGetAttribute(&cus, hipDeviceAttributeMultiprocessorCount, dev);
        (void)hipOccupancyMaxActiveBlocksPerMultiprocessor(&per_cu, yoco_megakernel, NTHR, 0);
        if (per_cu < 1) fprintf(stderr, "occupancy query returned %d\n", per_cu);
        grid_blocks = cus;
    }
    (void)hipMemsetAsync(d_ws, 0, 16384, stream);
    void* args[] = {&p};
    hipError_t e = hipLaunchCooperativeKernel((void*)yoco_megakernel, dim3(grid_blocks), dim3(NTHR), args, 0, stream);
    if (e != hipSuccess) fprintf(stderr, "cooperative launch failed: %s (grid %d)\n", hipGetErrorString(e), grid_blocks);
}
```

```cpp
#include <hip/hip_runtime.h>
#include <hip/hip_cooperative_groups.h>
#include <cstdio>
#include <cstdint>
namespace cg = cooperative_groups;

typedef unsigned short bf16_t;
typedef short bf16x8 __attribute__((ext_vector_type(8)));
typedef float f32x4 __attribute__((ext_vector_type(4)));
typedef float f32x16 __attribute__((ext_vector_type(16)));
typedef __bf16 bf16v2 __attribute__((ext_vector_type(2)));

constexpr int D = 1024, NB = 8, SEQ = 8192, T = NB * SEQ;
constexpr int GLA_NPROJ = 3088;
constexpr int NEXP = 16384;
constexpr float EPS = 1e-6f;
constexpr int NTHR = 512, NWAVE = 8;

constexpr size_t MiB = 1024ull * 1024ull;
constexpr size_t OFF_MOD = 64 * 1024;
constexpr size_t OFF_CMB = 576 * 1024;
constexpr size_t OFF_CMB2 = 640 * 1024;
constexpr size_t OFF_WB = 1 * MiB;
constexpr size_t WB_MAIN = 0;
constexpr size_t WB_V = WB_MAIN + 2304ull * 2048;
constexpr size_t WB_WOUT = WB_V + 1024ull * 2048;
constexpr size_t WB_KVK = WB_WOUT + 1024ull * 2048;
constexpr size_t WB_KVV = WB_KVK + 256ull * 2048;
constexpr size_t WB_SWAQ = WB_KVV + 256ull * 2048;
constexpr size_t WB_SWAO = WB_SWAQ + 1024ull * 2048;
constexpr size_t WB_PWQ = WB_SWAO + 1024ull * 2048;
constexpr size_t WB_SUBK = WB_PWQ + 2ull * 2048 * 2048;
constexpr float PWQ8_SCALE = 64.f, H8_SCALE = 4.f, O8_SCALE = 16.f, ON8_SCALE = 4.f;
constexpr size_t WB_END = WB_SUBK + 2ull * 2 * 128 * 128 * 2;
static_assert(WB_END <= 23 * MiB, "weights region");
constexpr size_t OFF_TBU = 24 * MiB;
constexpr size_t OFF_TBV = OFF_TBU + 64 * MiB;
constexpr float TBU_SCALE = 92.f, TBV_SCALE = 90.f;
constexpr size_t OFF_R0 = 152 * MiB;
constexpr size_t OFF_A0 = 408 * MiB;
constexpr size_t OFF_A1 = 536 * MiB;
constexpr size_t OFF_A2 = 664 * MiB;
constexpr size_t OFF_A3 = 792 * MiB;
constexpr size_t OFF_RTE = 920 * MiB;
constexpr size_t OFF_ROPE = 952 * MiB;
constexpr size_t WS_NEED = 984 * MiB;

struct Params {
    const float* x; const float* c; const int* pos; const float* mod_w; const float* mod_b; const float* norm_g;
    const float* gla_w_in; const float* gla_w_g2; const float* gla_b_g2; const float* gla_norm_g; const float* gla_w_out;
    const float* kv_mod_w; const float* kv_mod_b; const float* kv_norm_g; const float* kv_w;
    const float* swa_w_q; const float* swa_sinks; const float* swa_w_out;
    const float* peer_w_q; const float* peer_subkeys; const float* peer_u; const float* peer_v; const float* final_norm_g;
    float* out; char* ws;
};

constexpr int LDS_BYTES = 144 * 1024;
#ifndef REP_PEER
#define REP_PEER 1
#endif
#ifndef REP_ROUTE
#define REP_ROUTE 1
#endif
#ifndef REP_SWA
#define REP_SWA 1
#endif
#ifndef REP_G2
#define REP_G2 1
#endif
#ifndef REP_MOD
#define REP_MOD 1
#endif
#ifndef REP_G1
#define REP_G1 1
#endif
#ifndef REP_G3
#define REP_G3 1
#endif

__device__ __forceinline__ unsigned pack2(float lo, float hi) { bf16v2 v; v.x = (__bf16)lo; v.y = (__bf16)hi; return __builtin_bit_cast(unsigned, v); }
__device__ __forceinline__ float bf_lo(unsigned u) { return __uint_as_float(u << 16); }
__device__ __forceinline__ float bf_hi(unsigned u) { return __uint_as_float(u & 0xFFFF0000u); }
__device__ __forceinline__ float wave_sum(float v) {
#pragma unroll
    for (int o = 32; o > 0; o >>= 1) v += __shfl_xor(v, o);
    return v;
}
__device__ __forceinline__ int opaque_tid(int wv) { int t; asm volatile("v_mbcnt_lo_u32_b32 %0, -1, 0\n\tv_mbcnt_hi_u32_b32 %0, -1, %0\n\tv_lshl_or_b32 %0, %1, 6, %0" : "=&v"(t) : "s"(wv)); return t; }
__device__ __forceinline__ unsigned q4(float v) { return (unsigned)__float2int_rn(fminf(fmaxf(v, -7.f), 7.f)) & 15u; }
__device__ __forceinline__ unsigned q8(float v) { return (unsigned)__float2int_rn(fminf(fmaxf(v, -127.f), 127.f)) & 255u; }
__device__ __forceinline__ float silu(float v) { return v / (1.f + __expf(-v)); }
__device__ __forceinline__ float dpp_max16(float v) {
    v = fmaxf(v, __builtin_bit_cast(float, __builtin_amdgcn_update_dpp(0, __builtin_bit_cast(int, v), 0xB1, 0xF, 0xF, true)));
    v = fmaxf(v, __builtin_bit_cast(float, __builtin_amdgcn_update_dpp(0, __builtin_bit_cast(int, v), 0x4E, 0xF, 0xF, true)));
    v = fmaxf(v, __builtin_bit_cast(float, __builtin_amdgcn_update_dpp(0, __builtin_bit_cast(int, v), 0x141, 0xF, 0xF, true)));
    v = fmaxf(v, __builtin_bit_cast(float, __builtin_amdgcn_update_dpp(0, __builtin_bit_cast(int, v), 0x140, 0xF, 0xF, true)));
    return v;
}
__device__ __forceinline__ float dpp_sum16(float v) {
    v += __builtin_bit_cast(float, __builtin_amdgcn_update_dpp(0, __builtin_bit_cast(int, v), 0xB1, 0xF, 0xF, true));
    v += __builtin_bit_cast(float, __builtin_amdgcn_update_dpp(0, __builtin_bit_cast(int, v), 0x4E, 0xF, 0xF, true));
    v += __builtin_bit_cast(float, __builtin_amdgcn_update_dpp(0, __builtin_bit_cast(int, v), 0x141, 0xF, 0xF, true));
    v += __builtin_bit_cast(float, __builtin_amdgcn_update_dpp(0, __builtin_bit_cast(int, v), 0x140, 0xF, 0xF, true));
    return v;
}

#define XB_TMO      128
#define XB_XCNT(j)  (256  + 64 * (j))
#define XB_XSUB(j)  (1280 + 64 * (j))
#define XB_XGEN(j)  (2304 + 64 * (j))
#define XB_TOP      3328
#define XB_TOPGEN   3392
#define XCD_BAR_WORDS 3456
#define XB_SPIN_CAP (1u << 20)
#define LAS __attribute__((address_space(3)))
__device__ __forceinline__ unsigned xb_ld(unsigned* p)              { return __hip_atomic_load(p, __ATOMIC_RELAXED, __HIP_MEMORY_SCOPE_AGENT); }
__device__ __forceinline__ unsigned xb_add(unsigned* p, unsigned v) { return __hip_atomic_fetch_add(p, v, __ATOMIC_RELAXED, __HIP_MEMORY_SCOPE_AGENT); }
__device__ __forceinline__ unsigned xb_xcc_id() { return (unsigned)__builtin_amdgcn_s_getreg((3 << 11) | 20) & 0xFu; }
#define XB_SPIN(cond, bar) do { unsigned _sp = 0; while (cond) { __builtin_amdgcn_s_sleep(1); \
    if ((++_sp & 255u) == 0u) { if (xb_ld(&(bar)[XB_TMO])) break; if (_sp > XB_SPIN_CAP) { atomicAdd(&(bar)[XB_TMO], 1u); break; } } } } while (0)
struct XcdBarrier { unsigned* bar; unsigned x; volatile LAS unsigned* st; };
__device__ __forceinline__ XcdBarrier xcd_barrier_post(unsigned* bar, volatile LAS unsigned* st) {
    XcdBarrier b; b.bar = bar; b.x = xb_xcc_id(); b.st = st;
    if (threadIdx.x == 0) (void)xb_add(&bar[XB_XCNT(b.x)], 1u);
    return b;
}
__device__ __forceinline__ void xcd_barrier_complete(unsigned* bar, unsigned x, unsigned& nloc, unsigned& nx) {
    const unsigned G = gridDim.x * gridDim.y * gridDim.z;
    unsigned sum, cnt, mine, sp = 0u;
    for (;;) {
        sum = 0u; cnt = 0u; mine = 0u;
#pragma unroll
        for (unsigned j = 0; j < 16; ++j) { const unsigned c = xb_ld(&bar[XB_XCNT(j)]); sum += c; cnt += (c > 0u) ? 1u : 0u; mine = (j == x) ? c : mine; }
        if (sum == G) break;
        __builtin_amdgcn_s_sleep(1);
        if ((++sp & 255u) == 0u) { if (xb_ld(&bar[XB_TMO])) break; if (sp > XB_SPIN_CAP) { atomicAdd(&bar[XB_TMO], 1u); break; } }
    }
    nloc = mine > 0u ? mine : 1u; nx = cnt > 0u ? cnt : 1u;
}
__device__ __forceinline__ void xcd_barrier(const XcdBarrier& b) {
    asm volatile("s_waitcnt vmcnt(0)" ::: "memory");
    __syncthreads();
    if (threadIdx.x == 0) {
        unsigned* bar = b.bar;
        __builtin_amdgcn_s_waitcnt(0);
        unsigned nloc = b.st[0], nx = b.st[1];
        if (nloc == 0u) { xcd_barrier_complete(bar, b.x, nloc, nx); b.st[0] = nloc; b.st[1] = nx; }
        const unsigned old = xb_add(&bar[XB_XSUB(b.x)], 1u);
        const unsigned gen = old / nloc;
        if (old + 1u == (gen + 1u) * nloc) {
            __builtin_amdgcn_fence(__ATOMIC_RELEASE, "agent");
            asm volatile("s_waitcnt vmcnt(0)" ::: "memory");
            const unsigned og = xb_add(&bar[XB_TOP], 1u);
            const unsigned tg = og / nx;
            if (og + 1u == (tg + 1u) * nx) xb_add(&bar[XB_TOPGEN], 1u);
            else XB_SPIN(xb_ld(&bar[XB_TOPGEN]) == tg, bar);
            __builtin_amdgcn_fence(__ATOMIC_ACQUIRE, "agent");
            xb_add(&bar[XB_XGEN(b.x)], 1u);
            asm volatile("s_waitcnt vmcnt(0)" ::: "memory");
        } else {
            XB_SPIN(xb_ld(&bar[XB_XGEN(b.x)]) == gen, bar);
            __builtin_amdgcn_fence(__ATOMIC_ACQUIRE, "agent");
            asm volatile("s_waitcnt vmcnt(0)" ::: "memory");
        }
    }
    __syncthreads();
}

namespace pg8 {
#define PG8_LAS __attribute__((address_space(3)))
constexpr int BM = 256, BK = 64, HALF = 128, HTB = HALF * BK * 2, STAGE_BYTES = 8 * HTB, NXCD = 8, WGM = 2;
__device__ __forceinline__ int lds_byte(int r, int c) { const int st = (r >> 4) * 2 + (c >> 5), rr = r & 15, cc = c & 31, ob = rr * 64 + cc * 2; return st * 1024 + (ob ^ (((ob >> 9) & 1) << 5)); }
__device__ __forceinline__ void stage_rc(int b, int& R, int& C) { const int st = b / 1024, sb = b % 1024, swz = sb ^ (((sb >> 9) & 1) << 5); R = (st >> 1) * 16 + swz / 64; C = (st & 1) * 32 + (swz % 64) / 2; }
typedef int i32x8 __attribute__((ext_vector_type(8)));
typedef int i32x4 __attribute__((ext_vector_type(4)));
template <bool FP8> struct Frag;
template <> struct Frag<false> { bf16x8 k[2]; __device__ __forceinline__ void set2(bf16x8 x, bf16x8 y) { k[0] = x; k[1] = y; } };
template <> struct Frag<true> { i32x8 v; __device__ __forceinline__ void set2(bf16x8 x, bf16x8 y) { v = __builtin_shufflevector(__builtin_bit_cast(i32x4, x), __builtin_bit_cast(i32x4, y), 0, 1, 2, 3, 4, 5, 6, 7); } };
template <bool FP8> __device__ __forceinline__ f32x4 frag_mma(const Frag<FP8>& b, const Frag<FP8>& a, f32x4 c);
template <> __device__ __forceinline__ f32x4 frag_mma<false>(const Frag<false>& b, const Frag<false>& a, f32x4 c) {
    c = __builtin_amdgcn_mfma_f32_16x16x32_bf16(b.k[0], a.k[0], c, 0, 0, 0);
    return __builtin_amdgcn_mfma_f32_16x16x32_bf16(b.k[1], a.k[1], c, 0, 0, 0);
}
template <> __device__ __forceinline__ f32x4 frag_mma<true>(const Frag<true>& b, const Frag<true>& a, f32x4 c) {
    return __builtin_amdgcn_mfma_scale_f32_16x16x128_f8f6f4(b.v, a.v, c, 0, 0, 0, 0x7F7F7F7F, 0, 0x7F7F7F7F);
}
struct Unit { int pm, pn; };
struct Gemm { const bf16_t* A; const bf16_t* Bt; int M, N, K; };
struct StaticOrder {
    int nM, nN, nwg, G, c;
    __device__ void init(int M, int N, int G_, int c_) { nM = M / BM; nN = N / BM; nwg = nM * nN; G = G_; c = c_; }
    __device__ bool next(int i, Unit& u) const {
        const long L = (long)i * G + c; if (L >= nwg) return false;
        int wgid = (int)L; { const int q = nwg / NXCD, r = nwg % NXCD, xcd = wgid % NXCD, off = wgid / NXCD; wgid = (xcd < r ? xcd * (q + 1) : r * (q + 1) + (xcd - r) * q) + off; }
        const int nig = WGM * nN, gid = wgid / nig, fm = gid * WGM, gsz = (nM - fm) < WGM ? (nM - fm) : WGM;
        u.pm = fm + ((wgid % nig) % gsz); u.pn = (wgid % nig) / gsz; return true;
    }
};
template <class Epi, bool FP8 = false>
__device__ __forceinline__ void gemm_phase(const int wv, PG8_LAS unsigned char* lds, const Gemm g, const StaticOrder& S, const Epi& E) {
    const int tid = opaque_tid(wv), wid = wv, lane = tid & 63, wr = wid >> 2, wc = wid & 3, fr = lane & 15, fq = lane >> 4;
    const int K = g.K, nt = K / BK;
    unsigned voffA[2], voffB[2];
#pragma unroll
    for (int i = 0; i < 2; ++i) { int R, C; stage_rc(tid * 16 + i * 8192, R, C); const int rho = R & 31, Rb = (R & ~31) + 8 * ((rho & 15) >> 2) + 4 * (rho >> 4) + (rho & 3);
        voffA[i] = (unsigned)(R * K + C) * 2u; voffB[i] = (unsigned)(Rb * K + C) * 2u; }
    const size_t kstep = (size_t)(BK * 2);
    const size_t hstep = (size_t)HALF * K * 2;
    const size_t tstep = 2 * hstep;
    const unsigned ldsw = (unsigned)wid * 1024u;
    const int aoff = lds_byte(wr * 64 + fr, fq * 8), boff = lds_byte(wc * 32 + fr, fq * 8);
    PG8_LAS unsigned char* ldsB = lds + 4 * HTB + boff; asm volatile("" : "+v"(ldsB));
#define PG8_SA(b, h) (((b) * 2 + (h)) * HTB)
#define PG8_SB(b, h) ((4 + (b) * 2 + (h)) * HTB)
#define PG8_STAGE(bufoff, gbase, voff) do { _Pragma("unroll") for (int _i = 0; _i < 2; ++_i) { unsigned _vo = (voff)[_i]; asm volatile("" : "+v"(_vo)); \
        __builtin_amdgcn_global_load_lds((const unsigned*)((const char*)(gbase) + _vo), (PG8_LAS unsigned*)(lds + (bufoff) + ldsw + _i * 8192), 16, 0, 0); } } while (0)
#define PG8_LDA(dst, b, h) do { _Pragma("unroll") for (int m = 0; m < 4; ++m) dst[m].set2(*(const PG8_LAS bf16x8*)(lds + PG8_SA(b, h) + aoff + m * 2048), *(const PG8_LAS bf16x8*)(lds + PG8_SA(b, h) + aoff + m * 2048 + 1024)); } while (0)
#define PG8_LDB(dst, b, h) do { _Pragma("unroll") for (int n = 0; n < 2; ++n) dst[n].set2(*(const PG8_LAS bf16x8*)(ldsB + PG8_SA(b, h) + n * 2048), *(const PG8_LAS bf16x8*)(ldsB + PG8_SA(b, h) + n * 2048 + 1024)); } while (0)
#define PG8_MMA(ai, bj, At, Bt) do { __builtin_amdgcn_s_setprio(1); _Pragma("unroll") for (int m = 0; m < 4; ++m) _Pragma("unroll") for (int n = 0; n < 2; ++n) \
        acc[ai][bj][m][n] = frag_mma<FP8>(Bt[n], At[m], acc[ai][bj][m][n]); __builtin_amdgcn_s_setprio(0); } while (0)
#define PG8_WAIT_V(n) asm volatile("s_waitcnt vmcnt(" #n ")" ::: "memory")
#define PG8_WAIT_L(n) asm volatile("s_waitcnt lgkmcnt(" #n ")" ::: "memory")
#define PG8_BAR __builtin_amdgcn_s_barrier()
#define PG8_SCHED __builtin_amdgcn_sched_barrier(0)
    Unit cur, nxt; int ui = 0;
    if (!S.next(0, cur)) return;
    f32x4 acc[2][2][4][2];
#pragma unroll
    for (int a = 0; a < 2; ++a)
#pragma unroll
        for (int b = 0; b < 2; ++b)
#pragma unroll
            for (int m = 0; m < 4; ++m)
#pragma unroll
                for (int n = 0; n < 2; ++n) acc[a][b][m][n] = (f32x4){0.f, 0.f, 0.f, 0.f};
    Frag<FP8> At[4], B0[2], B1[2];
    const char* cA = (const char*)g.A + (size_t)cur.pm * tstep; const char* cB = (const char*)g.Bt + (size_t)cur.pn * tstep;
    PG8_STAGE(PG8_SB(0, 0), cB, voffB); PG8_STAGE(PG8_SA(0, 0), cA, voffA); PG8_STAGE(PG8_SB(0, 1), cB + hstep, voffB); PG8_STAGE(PG8_SA(0, 1), cA + hstep, voffA);
    if (wr == 1) PG8_BAR;
    PG8_WAIT_V(4); PG8_BAR;
    PG8_STAGE(PG8_SB(1, 0), cB + kstep, voffB); PG8_STAGE(PG8_SA(1, 0), cA + kstep, voffA); PG8_STAGE(PG8_SB(1, 1), cB + hstep + kstep, voffB);
    PG8_WAIT_V(6); PG8_BAR;
    for (;;) {
        const bool has_next = S.next(ui + 1, nxt);
        const char* nA = has_next ? (const char*)g.A + (size_t)nxt.pm * tstep : cA; const char* nB = has_next ? (const char*)g.Bt + (size_t)nxt.pn * tstep : cB;
        _Pragma("unroll 1") for (int t = 0; t < nt; t += 2) {
            const bool last = (t == nt - 2);
            const char* a1 = cA + (size_t)(t + 1) * kstep;
            const char* a2 = last ? nA : cA + (size_t)(t + 2) * kstep; const char* b2 = last ? nB : cB + (size_t)(t + 2) * kstep;
            const char* a3 = a2 + kstep; const char* b3 = b2 + kstep;
            PG8_LDB(B0, 0, 0); PG8_SCHED; PG8_LDA(At, 0, 0); PG8_STAGE(PG8_SA(1, 1), a1 + hstep, voffA);
            PG8_WAIT_L(8); PG8_BAR; PG8_WAIT_L(0); PG8_MMA(0, 0, At, B0); PG8_BAR; PG8_SCHED;
            PG8_LDB(B1, 0, 1); PG8_STAGE(PG8_SB(0, 0), b2, voffB);
            PG8_BAR; PG8_WAIT_L(0); PG8_MMA(0, 1, At, B1); PG8_BAR;
            PG8_LDA(At, 0, 1); PG8_STAGE(PG8_SA(0, 0), a2, voffA);
            PG8_BAR; PG8_WAIT_L(0); PG8_MMA(1, 0, At, B0); PG8_BAR; PG8_SCHED;
            PG8_STAGE(PG8_SB(0, 1), b2 + hstep, voffB);
            PG8_WAIT_V(6); PG8_BAR; PG8_MMA(1, 1, At, B1); PG8_BAR;
            PG8_LDB(B0, 1, 0); PG8_SCHED; PG8_LDA(At, 1, 0); PG8_STAGE(PG8_SA(0, 1), a2 + hstep, voffA);
            PG8_WAIT_L(8); PG8_BAR; PG8_WAIT_L(0); PG8_MMA(0, 0, At, B0); PG8_BAR; PG8_SCHED;
            PG8_LDB(B1, 1, 1); PG8_STAGE(PG8_SB(1, 0), b3, voffB);
            PG8_BAR; PG8_WAIT_L(0); PG8_MMA(0, 1, At, B1); PG8_BAR;
            PG8_LDA(At, 1, 1); PG8_STAGE(PG8_SA(1, 0), a3, voffA);
            PG8_BAR; PG8_WAIT_L(0); PG8_MMA(1, 0, At, B0); PG8_BAR; PG8_SCHED;
            PG8_STAGE(PG8_SB(1, 1), b3 + hstep, voffB);
            PG8_WAIT_V(6); PG8_BAR; PG8_MMA(1, 1, At, B1); PG8_BAR;
        }
        { const int t2 = opaque_tid(wv); E(acc, cur, wr, wc, t2 & 15, (t2 >> 4) & 3); }
        if (!has_next) break;
#pragma unroll
        for (int a = 0; a < 2; ++a)
#pragma unroll
            for (int b = 0; b < 2; ++b)
#pragma unroll
                for (int m = 0; m < 4; ++m)
#pragma unroll
                    for (int n = 0; n < 2; ++n) acc[a][b][m][n] = (f32x4){0.f, 0.f, 0.f, 0.f};
        cur = nxt; cA = nA; cB = nB; ++ui;
    }
    PG8_WAIT_V(0);
    if (wr == 0) PG8_BAR;
    PG8_BAR;
#undef PG8_SA
#undef PG8_SB
#undef PG8_STAGE
#undef PG8_LDA
#undef PG8_LDB
#undef PG8_MMA
#undef PG8_WAIT_V
#undef PG8_WAIT_L
#undef PG8_BAR
#undef PG8_SCHED
}
}

typedef unsigned u32x2 __attribute__((ext_vector_type(2)));
template <int CTRL> __device__ __forceinline__ unsigned dpp_quad(unsigned v) { return (unsigned)__builtin_amdgcn_mov_dpp((int)v, CTRL, 0xf, 0xf, true); }
template <class F> struct EpiAdapt {
    F f;
    __device__ __forceinline__ void operator()(const f32x4 (&acc)[2][2][4][2], const pg8::Unit& u, int wr, int wc, int fr, int fq) const {
        const int b = fr & 3, a4 = fr & 12;
        const bool odd = (b & 1) != 0, hi = (b & 2) != 0;
#pragma unroll
        for (int ai = 0; ai < 2; ++ai)
#pragma unroll
            for (int bj = 0; bj < 2; ++bj) {
                const int row0 = 256 * u.pm + 128 * ai + 64 * wr, col0 = 256 * u.pn + 128 * bj + 32 * wc;
                unsigned s[4][4];
#pragma unroll
                for (int m = 0; m < 4; ++m) { const uint4 o = f.pack(row0 + 16 * m + fr, col0 + 8 * fq, acc[ai][bj][m][0], acc[ai][bj][m][1]); s[m][0] = o.x; s[m][1] = o.y; s[m][2] = o.z; s[m][3] = o.w; }
#pragma unroll
                for (int d = 0; d < 4; ++d) {
                    u32x2 r;
                    r = __builtin_amdgcn_permlane16_swap(s[0][d], s[1][d], false, false); s[0][d] = r.x; s[1][d] = r.y;
                    r = __builtin_amdgcn_permlane16_swap(s[2][d], s[3][d], false, false); s[2][d] = r.x; s[3][d] = r.y;
                    r = __builtin_amdgcn_permlane32_swap(s[0][d], s[2][d], false, false); s[0][d] = r.x; s[2][d] = r.y;
                    r = __builtin_amdgcn_permlane32_swap(s[1][d], s[3][d], false, false); s[1][d] = r.x; s[3][d] = r.y;
                }
#pragma unroll
                for (int d = 0; d < 4; ++d) {
#pragma unroll
                    for (int j0 = 0; j0 < 4; j0 += 2) {
                        const unsigned recv = dpp_quad<0xB1>(odd ? s[j0][d] : s[j0 + 1][d]);
                        s[j0][d] = odd ? recv : s[j0][d]; s[j0 + 1][d] = odd ? s[j0 + 1][d] : recv;
                    }
#pragma unroll
                    for (int j0 = 0; j0 < 2; ++j0) {
                        const unsigned recv = dpp_quad<0x4E>(hi ? s[j0][d] : s[j0 + 2][d]);
                        s[j0][d] = hi ? recv : s[j0][d]; s[j0 + 2][d] = hi ? s[j0 + 2][d] : recv;
                    }
                }
#pragma unroll
                for (int j = 0; j < 4; ++j) {
                    void* a = f.addr(row0 + 16 * fq + a4 + j, col0 + 8 * b);
                    if (a) *(uint4*)a = make_uint4(s[j][0], s[j][1], s[j][2], s[j][3]);
                }
                __builtin_amdgcn_sched_barrier(0);
            }
    }
};
#ifndef REP_GEMM
#define REP_GEMM 1
#endif
template <class F>
__device__ __forceinline__ void run_gemm(const int wv, char* lds, const bf16_t* A, const bf16_t* Bt, int M, int N, const F& f) {
    pg8::StaticOrder S; S.init(M, N, gridDim.x, blockIdx.x);
    _Pragma("unroll 1") for (int rep = 0; rep < REP_GEMM; ++rep)
    pg8::gemm_phase(wv, (PG8_LAS unsigned char*)lds, pg8::Gemm{A, Bt, M, N, 1024}, S, EpiAdapt<F>{f});
}

template <class F>
__device__ __forceinline__ void run_gemm8(const int wv, char* lds, const unsigned char* A8, const unsigned char* Bt8, int M, int N, const F& f) {
    pg8::StaticOrder S; S.init(M, N, gridDim.x, blockIdx.x);
    pg8::gemm_phase<EpiAdapt<F>, true>(wv, (PG8_LAS unsigned char*)lds, pg8::Gemm{(const bf16_t*)A8, (const bf16_t*)Bt8, M, N, 512}, S, EpiAdapt<F>{f});
}
__device__ __forceinline__ uint4 pack8(f32x4 a, f32x4 b) { uint4 o; o.x = pack2(a[0], a[1]); o.y = pack2(a[2], a[3]); o.z = pack2(b[0], b[1]); o.w = pack2(b[2], b[3]); return o; }
struct EpiRowBf16 {
    bf16_t* dst; int ld;
    __device__ __forceinline__ uint4 pack(int m, int n, f32x4 v0, f32x4 v1) const { return pack8(v0, v1); }
    __device__ __forceinline__ void* addr(int m, int n) const { return dst + (size_t)m * ld + n; }
};
struct EpiRowBf16S {
    bf16_t* dst; int ld; float scale;
    __device__ __forceinline__ uint4 pack(int m, int n, f32x4 v0, f32x4 v1) const { return pack8(v0 * scale, v1 * scale); }
    __device__ __forceinline__ void* addr(int m, int n) const { return dst + (size_t)m * ld + n; }
};
struct EpiInMain {
    bf16_t* Q; bf16_t* K; bf16_t* OG; float* GL;
    __device__ __forceinline__ uint4 pack(int m, int n, f32x4 v0, f32x4 v1) const {
        if (n >= 2048 && n < 2064) { *(f32x4*)(GL + (size_t)m * 16 + (n - 2048)) = v0; *(f32x4*)(GL + (size_t)m * 16 + (n - 2048) + 4) = v1; }
        return pack8(v0, v1);
    }
    __device__ __forceinline__ void* addr(int m, int n) const {
        return (n < 512) ? Q + (size_t)m * 512 + n : (n < 1024) ? K + (size_t)m * 512 + (n - 512) : (n < 2048) ? OG + (size_t)m * 1024 + (n - 1024) : nullptr;
    }
};
struct EpiVT {
    bf16_t* dst; int ncols; float scale;
    __device__ __forceinline__ uint4 pack(int r, int tok, f32x4 v0, f32x4 v1) const { return pack8(v0 * scale, v1 * scale); }
    __device__ __forceinline__ void* addr(int r, int tok) const { const int b = tok >> 13, s = tok & (SEQ - 1); return dst + ((size_t)b * ncols + r) * SEQ + s; }
};
template <bool XIN_BF16> struct EpiResid {
    const void* xin; const float* gate; int gstride; bf16_t* xout; float vs;
    __device__ __forceinline__ void* addr(int m, int n) const { return xout + (size_t)m * D + n; }
    __device__ __forceinline__ uint4 pack(int m, int n, f32x4 v0, f32x4 v1) const {
        const int b = m >> 13;
        f32x4 x0, x1;
        if (XIN_BF16) { const uint4 u = *(const uint4*)((const bf16_t*)xin + (size_t)m * D + n); x0 = (f32x4){bf_lo(u.x), bf_hi(u.x), bf_lo(u.y), bf_hi(u.y)}; x1 = (f32x4){bf_lo(u.z), bf_hi(u.z), bf_lo(u.w), bf_hi(u.w)}; }
        else { x0 = *(const f32x4*)((const float*)xin + (size_t)m * D + n); x1 = *(const f32x4*)((const float*)xin + (size_t)m * D + n + 4); }
        const f32x4 g0 = *(const f32x4*)(gate + (size_t)b * gstride + n), g1 = *(const f32x4*)(gate + (size_t)b * gstride + n + 4);
        return pack8(x0 + (g0 * vs) * v0, x1 + (g1 * vs) * v1);
    }
};
struct EpiRopeBf16 {
    bf16_t* dst; int ld; float scale; const float* rope;
    __device__ __forceinline__ void* addr(int m, int n) const { return dst + (size_t)m * ld + n; }
    __device__ __forceinline__ uint4 pack(int m, int n, f32x4 v0, f32x4 v1) const {
        const int hd = n & 63;
        if (hd < 16) {
            const int i = hd >> 1;
            const float4 c = *(const float4*)(rope + (size_t)m * 16 + i), s = *(const float4*)(rope + (size_t)m * 16 + 8 + i);
            const float a0 = v0[0] * c.x - v0[1] * s.x, b0 = v0[1] * c.x + v0[0] * s.x;
            const float a1 = v0[2] * c.y - v0[3] * s.y, b1 = v0[3] * c.y + v0[2] * s.y;
            const float a2 = v1[0] * c.z - v1[1] * s.z, b2 = v1[1] * c.z + v1[0] * s.z;
            const float a3 = v1[2] * c.w - v1[3] * s.w, b3 = v1[3] * c.w + v1[2] * s.w;
            v0 = (f32x4){a0, b0, a1, b1}; v1 = (f32x4){a2, b2, a3, b3};
        }
        return pack8(v0 * scale, v1 * scale);
    }
};

__device__ __forceinline__ void phase_prep(const int wv, const Params& p, char* lds) {
    const int tid = opaque_tid(wv), G = gridDim.x;
    float* modv = (float*)(p.ws + OFF_MOD);
    float* kvmod = modv + 2 * 8 * 6144;
    {
        float* cact = (float*)lds;
        float* red = cact + 8192;
        for (int item = blockIdx.x; item < 256; item += G) {
            for (int i = tid; i < 8192; i += NTHR) cact[i] = silu(p.c[i]);
            __syncthreads();
            const int cl = tid & 63, kp = tid >> 6;
            const int j = item * 56 + (cl < 56 ? cl : 55);
            const float* W; const float* bias; float* o; int ld, col;
            if (j < 12288) { int l = j / 6144; col = j % 6144; ld = 6144; W = p.mod_w + (size_t)l * 1024 * 6144; bias = p.mod_b + l * 6144; o = modv + l * 8 * 6144; }
            else { col = j - 12288; ld = 2048; W = p.kv_mod_w; bias = p.kv_mod_b; o = kvmod; }
            float acc[8];
#pragma unroll
            for (int b = 0; b < 8; ++b) acc[b] = 0.f;
#pragma unroll 8
            for (int kk = 0; kk < 128; ++kk) {
                const int k = kp * 128 + kk;
                const float w = W[(size_t)k * ld + col];
#pragma unroll
                for (int b = 0; b < 8; ++b) acc[b] += cact[b * 1024 + k] * w;
            }
#pragma unroll
            for (int b = 0; b < 8; ++b) red[(kp * 8 + b) * 64 + cl] = acc[b];
            __syncthreads();
            {
                const int b = tid >> 6;
                float s = 0.f;
#pragma unroll
                for (int q = 0; q < 8; ++q) s += red[(q * 8 + b) * 64 + cl];
                if (cl < 56) o[b * ld + col] = s + bias[col];
            }
            __syncthreads();
        }
    }
    {
        float* tile = (float*)lds;
        const int NT_TOTAL = 86;
        for (int item = blockIdx.x; item < NT_TOTAL * 16; item += G) {
            const int nt = item >> 4, kt = item & 15;
            const float* src; int ldsrc, col0, nvalid, perm = 0, ntl, f8 = 0; size_t dsto;
            if (nt < 4)       { ntl = nt;      src = p.gla_w_in;  ldsrc = GLA_NPROJ; col0 = 0;    nvalid = 512;  dsto = WB_MAIN; }
            else if (nt < 8)  { ntl = nt - 4;  src = p.gla_w_in;  ldsrc = GLA_NPROJ; col0 = 512;  nvalid = 512;  dsto = WB_MAIN + 512ull * 2048; }
            else if (nt < 16) { ntl = nt - 8;  src = p.gla_w_in;  ldsrc = GLA_NPROJ; col0 = 2048; nvalid = 1024; dsto = WB_MAIN + 1024ull * 2048; }
            else if (nt < 18) { ntl = nt - 16; src = p.gla_w_in;  ldsrc = GLA_NPROJ; col0 = 3072; nvalid = 16;   dsto = WB_MAIN + 2048ull * 2048; }
            else if (nt < 26) { ntl = nt - 18; src = p.gla_w_in;  ldsrc = GLA_NPROJ; col0 = 1024; nvalid = 1024; dsto = WB_V; }
            else if (nt < 34) { ntl = nt - 26; src = p.gla_w_out; ldsrc = 1024; col0 = 0;   nvalid = 1024; dsto = WB_WOUT; f8 = 1; }
            else if (nt < 36) { ntl = nt - 34; src = p.kv_w;      ldsrc = 512;  col0 = 0;   nvalid = 256;  dsto = WB_KVK; perm = 1; f8 = 1; }
            else if (nt < 38) { ntl = nt - 36; src = p.kv_w;      ldsrc = 512;  col0 = 256; nvalid = 256;  dsto = WB_KVV; f8 = 1; }
            else if (nt < 46) { ntl = nt - 38; src = p.swa_w_q;   ldsrc = 1024; col0 = 0;   nvalid = 1024; dsto = WB_SWAQ; perm = 1; f8 = 1; }
            else if (nt < 54) { ntl = nt - 46; src = p.swa_w_out; ldsrc = 1024; col0 = 0;   nvalid = 1024; dsto = WB_SWAO; f8 = 1; }
            else if (nt < 70) { ntl = nt - 54; src = p.peer_w_q;  ldsrc = 2048; col0 = 0;   nvalid = 2048; dsto = WB_PWQ; }
            else              { ntl = nt - 70; src = p.peer_w_q + (size_t)1024 * 2048; ldsrc = 2048; col0 = 0; nvalid = 2048; dsto = WB_PWQ + 2048ull * 2048; f8 = 1; }
            bf16_t* dst = (bf16_t*)(p.ws + OFF_WB + dsto);
            const int n0 = ntl * 128, k0 = kt * 64;
            {
                const int nn = tid & 127;
                int n = n0 + nn;
                if (perm) { const int hd = n & 63; if (hd < 16) n = (n & ~63) + ((hd & 1) ? 8 + (hd >> 1) : (hd >> 1)); }
#pragma unroll
                for (int i = 0; i < 16; ++i) {
                    const int kk = (tid >> 7) + 4 * i;
                    tile[kk * 129 + nn] = (n < nvalid) ? src[(size_t)(k0 + kk) * ldsrc + col0 + n] : 0.f;
                }
            }
            __syncthreads();
            if (f8) {
                const int nn = tid >> 2, kc = (tid & 3) * 16;
                unsigned o[4];
#pragma unroll
                for (int q = 0; q < 4; ++q) {
                    const int lo = __builtin_amdgcn_cvt_pk_fp8_f32(tile[(kc + 4 * q + 0) * 129 + nn] * PWQ8_SCALE, tile[(kc + 4 * q + 1) * 129 + nn] * PWQ8_SCALE, 0, false);
                    o[q] = (unsigned)__builtin_amdgcn_cvt_pk_fp8_f32(tile[(kc + 4 * q + 2) * 129 + nn] * PWQ8_SCALE, tile[(kc + 4 * q + 3) * 129 + nn] * PWQ8_SCALE, lo, true);
                }
                *(uint4*)((unsigned char*)dst + (size_t)(n0 + nn) * 1024 + k0 + kc) = make_uint4(o[0], o[1], o[2], o[3]);
            } else
#pragma unroll
            for (int i = 0; i < 2; ++i) {
                const int nn = (tid >> 3) + 64 * i, kc = (tid & 7) * 8;
                uint4 o;
                o.x = pack2(tile[(kc + 0) * 129 + nn], tile[(kc + 1) * 129 + nn]);
                o.y = pack2(tile[(kc + 2) * 129 + nn], tile[(kc + 3) * 129 + nn]);
                o.z = pack2(tile[(kc + 4) * 129 + nn], tile[(kc + 5) * 129 + nn]);
                o.w = pack2(tile[(kc + 6) * 129 + nn], tile[(kc + 7) * 129 + nn]);
                *(uint4*)(dst + (size_t)(n0 + nn) * 1024 + k0 + kc) = o;
            }
            __syncthreads();
        }
    }
    {
        const size_t gt = (size_t)blockIdx.x * NTHR + tid, gs = (size_t)G * NTHR;
        const size_t NTAB = (size_t)2 * NEXP * 1024 / 16;
        {
            const float* src = p.peer_v;
            uint4* dst = (uint4*)(p.ws + OFF_TBV);
#pragma unroll 4
            for (size_t i = gt; i < NTAB; i += gs) {
                unsigned o[4];
#pragma unroll
                for (int q = 0; q < 4; ++q) {
                    const size_t row = i >> 6; const int ch = (int)(i & 63), c = ch >> 4, li = ch & 15;
                    const float4 a = ((const float4*)src)[row * 256 + 64 * c + 16 * q + li];
                    o[q] = q8(a.x * TBV_SCALE) | (q8(a.y * TBV_SCALE) << 8) | (q8(a.z * TBV_SCALE) << 16) | (q8(a.w * TBV_SCALE) << 24);
                }
                dst[i] = make_uint4(o[0], o[1], o[2], o[3]);
            }
        }
        {
            const float* src = p.peer_u;
            uint4* dst = (uint4*)(p.ws + OFF_TBU);
#pragma unroll 2
            for (size_t i = gt; i < NTAB / 2; i += gs) {
                unsigned o[4];
#pragma unroll
                for (int q = 0; q < 4; ++q) {
                    const size_t row = i >> 5; const int ci = (int)(i & 31), c = ci >> 4, li = ci & 15;
                    const size_t f4 = row * 256 + 64 * (2 * c + (q >> 1)) + 32 * (q & 1) + li;
                    const float4 a = ((const float4*)src)[f4], b = ((const float4*)src)[f4 + 16];
                    o[q] = q4(a.x * TBU_SCALE) | (q4(a.y * TBU_SCALE) << 4) | (q4(a.z * TBU_SCALE) << 8) | (q4(a.w * TBU_SCALE) << 12)
                         | (q4(b.x * TBU_SCALE) << 16) | (q4(b.y * TBU_SCALE) << 20) | (q4(b.z * TBU_SCALE) << 24) | (q4(b.w * TBU_SCALE) << 28);
                }
                dst[i] = make_uint4(o[0], o[1], o[2], o[3]);
            }
        }
        {
            float* rope = (float*)(p.ws + OFF_ROPE);
            for (size_t i = gt; i < (size_t)T * 8; i += gs) {
                const int t = (int)(i >> 3), f = (int)(i & 7);
                const float ang = (float)p.pos[t] * exp2f(-(float)f * 2.3664460711655218f);
                float s, c; sincosf(ang, &s, &c);
                rope[(size_t)t * 16 + f] = c; rope[(size_t)t * 16 + 8 + f] = s;
            }
        }
        uint4* dsk = (uint4*)(p.ws + OFF_WB + WB_SUBK);
        for (size_t i = gt; i < 65536 / 8; i += gs) {
            float4 a = ((const float4*)p.peer_subkeys)[2 * i], b = ((const float4*)p.peer_subkeys)[2 * i + 1];
            constexpr float SKS = 1.f;
            uint4 o; o.x = pack2(a.x * SKS, a.y * SKS); o.y = pack2(a.z * SKS, a.w * SKS); o.z = pack2(b.x * SKS, b.y * SKS); o.w = pack2(b.z * SKS, b.w * SKS);
            dsk[i] = o;
        }
    }
}

template <bool XIN_BF16>
__device__ __forceinline__ void phase_modulate(const int wv, const void* xin, const float* g, const float* shift, const float* scale, int bstride, bf16_t* out, unsigned char* out8 = nullptr) {
    const int tid_ = opaque_tid(wv), lane = tid_ & 63, wid = tid_ >> 6;
    const int gw = blockIdx.x * NWAVE + wid, nw = gridDim.x * NWAVE;
    for (int t0 = gw * 2; t0 < T * REP_MOD; t0 += nw * 2) {
        const int t = t0 & (T - 1);
        const int b = t >> 13;
        float4 v[2][4]; float ss[2] = {0.f, 0.f};
#pragma unroll
        for (int r = 0; r < 2; ++r) {
            if (XIN_BF16) {
                const uint2* xr = (const uint2*)((const bf16_t*)xin + (size_t)(t + r) * D);
#pragma unroll
                for (int j = 0; j < 4; ++j) { const uint2 u = xr[lane + 64 * j]; v[r][j] = make_float4(bf_lo(u.x), bf_hi(u.x), bf_lo(u.y), bf_hi(u.y)); }
            } else {
                const float4* xr = (const float4*)((const float*)xin + (size_t)(t + r) * D);
#pragma unroll
                for (int j = 0; j < 4; ++j) v[r][j] = xr[lane + 64 * j];
            }
        }
#pragma unroll
        for (int r = 0; r < 2; ++r)
#pragma unroll
            for (int j = 0; j < 4; ++j) ss[r] += v[r][j].x * v[r][j].x + v[r][j].y * v[r][j].y + v[r][j].z * v[r][j].z + v[r][j].w * v[r][j].w;
        ss[0] = wave_sum(ss[0]); ss[1] = wave_sum(ss[1]);
        const float rinv[2] = {rsqrtf(ss[0] * (1.f / D) + EPS), rsqrtf(ss[1] * (1.f / D) + EPS)};
#pragma unroll
        for (int j = 0; j < 4; ++j) {
            const float4 gg = ((const float4*)g)[lane + 64 * j];
            const float4 sc = ((const float4*)(scale + (size_t)b * bstride))[lane + 64 * j];
            const float4 sh = ((const float4*)(shift + (size_t)b * bstride))[lane + 64 * j];
            const float m0 = gg.x * (1.f + sc.x), m1 = gg.y * (1.f + sc.y), m2 = gg.z * (1.f + sc.z), m3 = gg.w * (1.f + sc.w);
#pragma unroll
            for (int r = 0; r < 2; ++r) {
                const float h0 = v[r][j].x * rinv[r] * m0 + sh.x, h1 = v[r][j].y * rinv[r] * m1 + sh.y, h2 = v[r][j].z * rinv[r] * m2 + sh.z, h3 = v[r][j].w * rinv[r] * m3 + sh.w;
                uint2 o;
                o.x = pack2(h0, h1);
                o.y = pack2(h2, h3);
                if (out) ((uint2*)(out + (size_t)(t + r) * D))[lane + 64 * j] = o;
                if (out8) {
                    const int lo = __builtin_amdgcn_cvt_pk_fp8_f32(h0 * H8_SCALE, h1 * H8_SCALE, 0, false);
                    ((unsigned*)(out8 + (size_t)(t + r) * D))[lane + 64 * j] = (unsigned)__builtin_amdgcn_cvt_pk_fp8_f32(h2 * H8_SCALE, h3 * H8_SCALE, lo, true);
                }
            }
        }
    }
}

__device__ __forceinline__ float logsigmoidf(float z) { return fminf(z, 0.f) - __logf(1.f + __expf(-fabsf(z))); }
constexpr int G1LD = 136;
__device__ __forceinline__ void phase_gla_g1(const int wv, const Params& p, char* lds, const float* GL, bf16_t* Pm, float* DEC) {
    const int tid = opaque_tid(wv), lane = tid & 63, sub = tid >> 8, t8 = tid & 255, wid4 = (tid >> 6) & 3;
    bf16_t* Q = (bf16_t*)(p.ws + OFF_A1); const bf16_t* K = Q + (size_t)T * 512;
    bf16_t* KD = (bf16_t*)(p.ws + OFF_A0);
    bf16_t* QT = KD + (size_t)T * 512;
    float* gl_s = (float*)(lds + sub * 40960);
    float* tot_s = gl_s + 1024;
    bf16_t* qt_s = (bf16_t*)(tot_s + 256);
    bf16_t* kt_s = qt_s + 64 * G1LD;
    const int d = t8 & 127, half = t8 >> 7;
#define G1_BARRIER() do { asm volatile("s_waitcnt lgkmcnt(0)" ::: "memory"); __builtin_amdgcn_s_barrier(); asm volatile("" ::: "memory"); } while (0)
    const int NIT = (T / 64) * 2 * REP_G1;
    uint4 pq0, pq1, pq2, pq3, pk0, pk1, pk2, pk3; float4 pg;
#define G1_LOAD(q_, k_, i_, t_, h_) do { const int idx_ = t8 + 256 * (i_), row_ = idx_ >> 4, ch_ = idx_ & 15; \
        q_ = *(const uint4*)(Q + (size_t)((t_) + row_) * 512 + (h_) * 128 + ch_ * 8); k_ = *(const uint4*)(K + (size_t)((t_) + row_) * 512 + (h_) * 128 + ch_ * 8); } while (0)
#define G1_STAGE(q_, k_, i_) do { const int idx_ = t8 + 256 * (i_), row_ = idx_ >> 4, ch_ = idx_ & 15; *(uint4*)(qt_s + row_ * G1LD + ch_ * 8) = q_; *(uint4*)(kt_s + row_ * G1LD + ch_ * 8) = k_; } while (0)
    {
        const int item = (blockIdx.x % ((T / 64) * 2)) * 2 + sub, ci = item >> 2, h = item & 3, t0 = ci * 64;
        pg = ((const float4*)(GL + (size_t)t0 * 16))[t8];
        G1_LOAD(pq0, pk0, 0, t0, h); G1_LOAD(pq1, pk1, 1, t0, h); G1_LOAD(pq2, pk2, 2, t0, h); G1_LOAD(pq3, pk3, 3, t0, h);
    }
    int hcur = -1; float w2[16]; float bias = 0.f;
    for (int pi0 = blockIdx.x; pi0 < NIT; pi0 += gridDim.x) {
        const int pi = pi0 % ((T / 64) * 2);
        const int item = pi * 2 + sub;
        const int ci = item >> 2, h = item & 3, t0 = ci * 64;
        ((float4*)gl_s)[t8] = pg;
        G1_STAGE(pq0, pk0, 0); G1_STAGE(pq1, pk1, 1); G1_STAGE(pq2, pk2, 2); G1_STAGE(pq3, pk3, 3);
        {
            const int pn = ((pi0 + (int)gridDim.x < NIT) ? pi0 + (int)gridDim.x : pi0) % ((T / 64) * 2);
            const int itn = pn * 2 + sub, cn = itn >> 2, hn = itn & 3, tn = cn * 64;
            pg = ((const float4*)(GL + (size_t)tn * 16))[t8];
            G1_LOAD(pq0, pk0, 0, tn, hn); G1_LOAD(pq1, pk1, 1, tn, hn); G1_LOAD(pq2, pk2, 2, tn, hn); G1_LOAD(pq3, pk3, 3, tn, hn);
        }
        if (h != hcur) {
#pragma unroll
            for (int r = 0; r < 16; ++r) w2[r] = p.gla_w_g2[r * 512 + h * 128 + d];
            bias = p.gla_b_g2[h * 128 + d];
            hcur = h;
        }
        G1_BARRIER();
        float la[32]; float tot = 0.f;
#pragma unroll
        for (int i = 0; i < 32; ++i) {
            const int m = half * 32 + i; float z = bias;
#pragma unroll
            for (int r4 = 0; r4 < 4; ++r4) {
                const float4 g4 = ((const float4*)gl_s)[m * 4 + r4];
                z += g4.x * w2[4 * r4] + g4.y * w2[4 * r4 + 1] + g4.z * w2[4 * r4 + 2] + g4.w * w2[4 * r4 + 3];
            }
            la[i] = logsigmoidf(z) * (1.f / 16.f); tot += la[i];
        }
        tot_s[half * 128 + d] = tot;
        G1_BARRIER();
        const float tot0 = tot_s[d], tot1 = tot_s[128 + d];
        const float blast = tot0 + tot1;
        float cum = half ? tot0 : 0.f;
        bf16_t* kdw = KD + (size_t)item * 8192 + (size_t)d * 64 + half * 32;
#pragma unroll
        for (int i8 = 0; i8 < 4; ++i8) {
            float kd[8];
#pragma unroll
            for (int ii = 0; ii < 8; ++ii) {
                const int i = i8 * 8 + ii, m = half * 32 + i;
                cum += la[i];
                const float qv = __uint_as_float((unsigned)qt_s[m * G1LD + d] << 16);
                const float kv = __uint_as_float((unsigned)kt_s[m * G1LD + d] << 16);
                const float qt = qv * 0.08838834764831845f * __expf(cum);
                const float ktv = kv * __expf(-cum);
                kd[ii] = kv * __expf(blast - cum);
                qt_s[m * G1LD + d] = (bf16_t)(pack2(qt, 0.f) & 0xFFFFu);
                kt_s[m * G1LD + d] = (bf16_t)(pack2(ktv, 0.f) & 0xFFFFu);
            }
            uint4 o; o.x = pack2(kd[0], kd[1]); o.y = pack2(kd[2], kd[3]); o.z = pack2(kd[4], kd[5]); o.w = pack2(kd[6], kd[7]);
            *(uint4*)(kdw + i8 * 8) = o;
        }
        if (half == 0) DEC[(size_t)item * 128 + d] = __expf(blast);
        G1_BARRIER();
#pragma unroll
        for (int i = 0; i < 4; ++i) {
            const int idx = t8 + 256 * i, row = idx >> 4, ch = idx & 15;
            *(uint4*)(QT + (size_t)(t0 + row) * 512 + h * 128 + ch * 8) = *(const uint4*)(qt_s + row * G1LD + ch * 8);
        }
        {
            const int fr = lane & 15, fq = lane >> 4;
            bf16x8 qb[4];
#pragma unroll
            for (int ks = 0; ks < 4; ++ks) qb[ks] = *(const bf16x8*)(qt_s + (16 * wid4 + fr) * G1LD + 32 * ks + 8 * fq);
            const int c = 16 * wid4 + fr;
            bf16_t* prow = Pm + (size_t)item * 4096 + (size_t)c * 64;
#pragma unroll
            for (int mt = 0; mt < 4; ++mt) {
                f32x4 acc = (f32x4){0.f, 0.f, 0.f, 0.f};
                if (mt <= wid4) {
#pragma unroll
                    for (int ks = 0; ks < 4; ++ks) {
                        const bf16x8 ka = *(const bf16x8*)(kt_s + (16 * mt + fr) * G1LD + 32 * ks + 8 * fq);
                        acc = __builtin_amdgcn_mfma_f32_16x16x32_bf16(ka, qb[ks], acc, 0, 0, 0);
                    }
                }
                const int mb = 16 * mt + 4 * fq;
                float v0 = (mb + 0 <= c) ? acc[0] : 0.f, v1 = (mb + 1 <= c) ? acc[1] : 0.f, v2 = (mb + 2 <= c) ? acc[2] : 0.f, v3 = (mb + 3 <= c) ? acc[3] : 0.f;
                uint2 o; o.x = pack2(v0, v1); o.y = pack2(v2, v3);
                *(uint2*)(prow + mb) = o;
            }
        }
        G1_BARRIER();
    }
}

constexpr int G2LD = 136, G2S = 72;
constexpr int G2_VT = 0, G2_P = G2_VT + 32 * G2S * 2, G2_Q = G2_P + 64 * G2S * 2, G2_KD = G2_Q + 64 * G2LD * 2, G2_DEC = G2_KD + 128 * G2S * 2, G2_STAGE = G2_DEC + 512;
static_assert(G2_STAGE % 16 == 0 && 2 * 32 * G2LD * 2 + 2 * G2_STAGE <= LDS_BYTES - 16, "G2 LDS");
struct G2Piece { const char* src; int stride; int dst; };
__device__ __forceinline__ G2Piece g2_piece(int c, const bf16_t* VT, const bf16_t* Pm, const bf16_t* Q, const bf16_t* KD, const float* DEC, int b, int h, int sl) {
    const size_t item0 = ((size_t)(b * 128) * 4 + h);
    const size_t t0 = (size_t)b * SEQ;
    G2Piece r;
    if (c < 256) { const int row = c >> 3, ch = c & 7; r.src = (const char*)(VT + ((size_t)b * 1024 + h * 256 + sl * 32 + row) * SEQ + ch * 8); r.stride = 64 * 2; r.dst = G2_VT + (row * G2S + ch * 8) * 2; }
    else if (c < 768) { const int cc = c - 256, row = cc >> 3, ch = cc & 7; r.src = (const char*)(Pm + item0 * 4096 + row * 64 + ch * 8); r.stride = 4 * 4096 * 2; r.dst = G2_P + (row * G2S + ch * 8) * 2; }
    else if (c < 1792) { const int cc = c - 768, row = cc >> 4, ch = cc & 15; r.src = (const char*)(Q + (t0 + row) * 512 + h * 128 + ch * 8); r.stride = 64 * 512 * 2; r.dst = G2_Q + (row * G2LD + ch * 8) * 2; }
    else if (c < 2816) { const int cc = c - 1792, row = cc >> 3, ch = cc & 7; r.src = (const char*)(KD + item0 * 8192 + row * 64 + ch * 8); r.stride = 4 * 8192 * 2; r.dst = G2_KD + (row * G2S + ch * 8) * 2; }
    else { const int cc = c - 2816; r.src = (const char*)(DEC + item0 * 128 + cc * 4); r.stride = 4 * 128 * 4; r.dst = G2_DEC + cc * 16; }
    return r;
}
__device__ __forceinline__ void phase_gla_g2(const int wv, const Params& p, char* lds, const bf16_t* Pm, const float* DEC, bf16_t* O) {
    const int tid = opaque_tid(wv), lane = tid & 63, wid = tid >> 6, fr = lane & 15, fq = lane >> 4;
    const int mo = wid & 1, ct = wid >> 1;
    const bf16_t* KD = (const bf16_t*)(p.ws + OFF_A0);
    const bf16_t* Q = KD + (size_t)T * 512;
    const bf16_t* VT = (const bf16_t*)(p.ws + OFF_A2);
    bf16_t* sT = (bf16_t*)lds;
    char* stage0 = lds + 2 * 32 * G2LD * 2;
    for (int item0 = blockIdx.x; item0 < 256 * REP_G2; item0 += gridDim.x) {
        const int item = item0 & 255;
        const int xcd = item & 7, yy = item >> 3, bh = xcd * 4 + (yy >> 3), sl = yy & 7;
        const int b = bh >> 2, h = bh & 3;
        __syncthreads();
        for (int i = tid; i < 2 * 32 * G2LD / 2; i += NTHR) ((unsigned*)sT)[i] = 0u;
        f32x4 s[2];
        s[0] = (f32x4){0.f, 0.f, 0.f, 0.f}; s[1] = (f32x4){0.f, 0.f, 0.f, 0.f};
        uint4 ra0, ra1, ra2, ra3, ra4, ra5, rb0, rb1, rb2, rb3, rb4, rb5;
        const G2Piece pc0 = g2_piece(min(tid + NTHR * 0, 2847), VT, Pm, Q, KD, DEC, b, h, sl);
        const G2Piece pc1 = g2_piece(min(tid + NTHR * 1, 2847), VT, Pm, Q, KD, DEC, b, h, sl);
        const G2Piece pc2 = g2_piece(min(tid + NTHR * 2, 2847), VT, Pm, Q, KD, DEC, b, h, sl);
        const G2Piece pc3 = g2_piece(min(tid + NTHR * 3, 2847), VT, Pm, Q, KD, DEC, b, h, sl);
        const G2Piece pc4 = g2_piece(min(tid + NTHR * 4, 2847), VT, Pm, Q, KD, DEC, b, h, sl);
        const G2Piece pc5 = g2_piece(min(tid + NTHR * 5, 2847), VT, Pm, Q, KD, DEC, b, h, sl);
        ra0 = *(const uint4*)(pc0.src + (size_t)(0) * pc0.stride);
        ra1 = *(const uint4*)(pc1.src + (size_t)(0) * pc1.stride);
        ra2 = *(const uint4*)(pc2.src + (size_t)(0) * pc2.stride);
        ra3 = *(const uint4*)(pc3.src + (size_t)(0) * pc3.stride);
        ra4 = *(const uint4*)(pc4.src + (size_t)(0) * pc4.stride);
        ra5 = *(const uint4*)(pc5.src + (size_t)(0) * pc5.stride);
        *(uint4*)(stage0 + pc0.dst) = ra0;
        *(uint4*)(stage0 + pc1.dst) = ra1;
        *(uint4*)(stage0 + pc2.dst) = ra2;
        *(uint4*)(stage0 + pc3.dst) = ra3;
        *(uint4*)(stage0 + pc4.dst) = ra4;
        *(uint4*)(stage0 + pc5.dst) = ra5;
        rb0 = *(const uint4*)(pc0.src + (size_t)(1) * pc0.stride);
        rb1 = *(const uint4*)(pc1.src + (size_t)(1) * pc1.stride);
        rb2 = *(const uint4*)(pc2.src + (size_t)(1) * pc2.stride);
        rb3 = *(const uint4*)(pc3.src + (size_t)(1) * pc3.stride);
        rb4 = *(const uint4*)(pc4.src + (size_t)(1) * pc4.stride);
        rb5 = *(const uint4*)(pc5.src + (size_t)(1) * pc5.stride);
        __syncthreads();
        for (int n2 = 0; n2 < 128; n2 += 2) {
          {
            const int n = n2;
            const char* st = stage0; char* stn = stage0 + G2_STAGE;
            const int nl = min(n + 2, 127);
            ra0 = *(const uint4*)(pc0.src + (size_t)(nl) * pc0.stride);
            ra1 = *(const uint4*)(pc1.src + (size_t)(nl) * pc1.stride);
            ra2 = *(const uint4*)(pc2.src + (size_t)(nl) * pc2.stride);
            ra3 = *(const uint4*)(pc3.src + (size_t)(nl) * pc3.stride);
            ra4 = *(const uint4*)(pc4.src + (size_t)(nl) * pc4.stride);
            ra5 = *(const uint4*)(pc5.src + (size_t)(nl) * pc5.stride);
            const bf16_t* vT_s = (const bf16_t*)(st + G2_VT); const bf16_t* P_s = (const bf16_t*)(st + G2_P);
            const bf16_t* q_s = (const bf16_t*)(st + G2_Q); const bf16_t* kd_s = (const bf16_t*)(st + G2_KD);
            const bf16_t* sr = sT + (n & 1) * (32 * G2LD);
            bf16_t* sw = sT + ((n + 1) & 1) * (32 * G2LD);
            bf16x8 va[2][2];
#pragma unroll
            for (int nt = 0; nt < 2; ++nt)
#pragma unroll
                for (int ks = 0; ks < 2; ++ks) va[nt][ks] = *(const bf16x8*)(vT_s + (16 * nt + fr) * G2S + 32 * ks + 8 * fq);
            f32x4 o = (f32x4){0.f, 0.f, 0.f, 0.f};
#pragma unroll
            for (int ks = 0; ks < 2; ++ks) {
                const bf16x8 pb = *(const bf16x8*)(P_s + (16 * ct + fr) * G2S + 32 * ks + 8 * fq);
                const bf16x8 vo = *(const bf16x8*)(vT_s + (16 * mo + fr) * G2S + 32 * ks + 8 * fq);
                o = __builtin_amdgcn_mfma_f32_16x16x32_bf16(vo, pb, o, 0, 0, 0);
            }
#pragma unroll
            for (int ks = 0; ks < 4; ++ks) {
                const bf16x8 sa = *(const bf16x8*)(sr + (16 * mo + fr) * G2LD + 32 * ks + 8 * fq);
                const bf16x8 qb = *(const bf16x8*)(q_s + (16 * ct + fr) * G2LD + 32 * ks + 8 * fq);
                o = __builtin_amdgcn_mfma_f32_16x16x32_bf16(sa, qb, o, 0, 0, 0);
            }
            {
                uint2 ov; ov.x = pack2(o[0], o[1]); ov.y = pack2(o[2], o[3]);
                *(uint2*)(O + ((size_t)b * SEQ + n * 64 + 16 * ct + fr) * 1024 + h * 256 + sl * 32 + 16 * mo + 4 * fq) = ov;
            }
            const f32x4 dv = *(const f32x4*)(st + G2_DEC + (16 * wid + 4 * fq) * 4);
            bf16x8 ka[2];
#pragma unroll
            for (int ks = 0; ks < 2; ++ks) ka[ks] = *(const bf16x8*)(kd_s + (16 * wid + fr) * G2S + 32 * ks + 8 * fq);
#pragma unroll
            for (int nt = 0; nt < 2; ++nt) {
                f32x4 a = s[nt] * dv;
#pragma unroll
                for (int ks = 0; ks < 2; ++ks) a = __builtin_amdgcn_mfma_f32_16x16x32_bf16(ka[ks], va[nt][ks], a, 0, 0, 0);
                s[nt] = a;
                uint2 sv; sv.x = pack2(a[0], a[1]); sv.y = pack2(a[2], a[3]);
                *(uint2*)(sw + (16 * nt + fr) * G2LD + 16 * wid + 4 * fq) = sv;
            }
            *(uint4*)(stn + pc0.dst) = rb0;
            *(uint4*)(stn + pc1.dst) = rb1;
            *(uint4*)(stn + pc2.dst) = rb2;
            *(uint4*)(stn + pc3.dst) = rb3;
            *(uint4*)(stn + pc4.dst) = rb4;
            *(uint4*)(stn + pc5.dst) = rb5;
            __syncthreads();
          }
          {
            const int n = n2 + 1;
            const char* st = stage0 + G2_STAGE; char* stn = stage0;
            const int nl = min(n + 2, 127);
            rb0 = *(const uint4*)(pc0.src + (size_t)(nl) * pc0.stride);
            rb1 = *(const uint4*)(pc1.src + (size_t)(nl) * pc1.stride);
            rb2 = *(const uint4*)(pc2.src + (size_t)(nl) * pc2.stride);
            rb3 = *(const uint4*)(pc3.src + (size_t)(nl) * pc3.stride);
            rb4 = *(const uint4*)(pc4.src + (size_t)(nl) * pc4.stride);
            rb5 = *(const uint4*)(pc5.src + (size_t)(nl) * pc5.stride);
            const bf16_t* vT_s = (const bf16_t*)(st + G2_VT); const bf16_t* P_s = (const bf16_t*)(st + G2_P);
            const bf16_t* q_s = (const bf16_t*)(st + G2_Q); const bf16_t* kd_s = (const bf16_t*)(st + G2_KD);
            const bf16_t* sr = sT + (n & 1) * (32 * G2LD);
            bf16_t* sw = sT + ((n + 1) & 1) * (32 * G2LD);
            bf16x8 va[2][2];
#pragma unroll
            for (int nt = 0; nt < 2; ++nt)
#pragma unroll
                for (int ks = 0; ks < 2; ++ks) va[nt][ks] = *(const bf16x8*)(vT_s + (16 * nt + fr) * G2S + 32 * ks + 8 * fq);
            f32x4 o = (f32x4){0.f, 0.f, 0.f, 0.f};
#pragma unroll
            for (int ks = 0; ks < 2; ++ks) {
                const bf16x8 pb = *(const bf16x8*)(P_s + (16 * ct + fr) * G2S + 32 * ks + 8 * fq);
                const bf16x8 vo = *(const bf16x8*)(vT_s + (16 * mo + fr) * G2S + 32 * ks + 8 * fq);
                o = __builtin_amdgcn_mfma_f32_16x16x32_bf16(vo, pb, o, 0, 0, 0);
            }
#pragma unroll
            for (int ks = 0; ks < 4; ++ks) {
                const bf16x8 sa = *(const bf16x8*)(sr + (16 * mo + fr) * G2LD + 32 * ks + 8 * fq);
                const bf16x8 qb = *(const bf16x8*)(q_s + (16 * ct + fr) * G2LD + 32 * ks + 8 * fq);
                o = __builtin_amdgcn_mfma_f32_16x16x32_bf16(sa, qb, o, 0, 0, 0);
            }
            {
                uint2 ov; ov.x = pack2(o[0], o[1]); ov.y = pack2(o[2], o[3]);
                *(uint2*)(O + ((size_t)b * SEQ + n * 64 + 16 * ct + fr) * 1024 + h * 256 + sl * 32 + 16 * mo + 4 * fq) = ov;
            }
            const f32x4 dv = *(const f32x4*)(st + G2_DEC + (16 * wid + 4 * fq) * 4);
            bf16x8 ka[2];
#pragma unroll
            for (int ks = 0; ks < 2; ++ks) ka[ks] = *(const bf16x8*)(kd_s + (16 * wid + fr) * G2S + 32 * ks + 8 * fq);
#pragma unroll
            for (int nt = 0; nt < 2; ++nt) {
                f32x4 a = s[nt] * dv;
#pragma unroll
                for (int ks = 0; ks < 2; ++ks) a = __builtin_amdgcn_mfma_f32_16x16x32_bf16(ka[ks], va[nt][ks], a, 0, 0, 0);
                s[nt] = a;
                uint2 sv; sv.x = pack2(a[0], a[1]); sv.y = pack2(a[2], a[3]);
                *(uint2*)(sw + (16 * nt + fr) * G2LD + 16 * wid + 4 * fq) = sv;
            }
            *(uint4*)(stn + pc0.dst) = ra0;
            *(uint4*)(stn + pc1.dst) = ra1;
            *(uint4*)(stn + pc2.dst) = ra2;
            *(uint4*)(stn + pc3.dst) = ra3;
            *(uint4*)(stn + pc4.dst) = ra4;
            *(uint4*)(stn + pc5.dst) = ra5;
            __syncthreads();
          }
        }
    }
}

__device__ __forceinline__ void phase_gla_g3(const int wv, const Params& p, const bf16_t* O, const bf16_t* OG, bf16_t* ON) {
    const int tid_ = opaque_tid(wv), lane = tid_ & 63, wid = tid_ >> 6;
    const int gw = blockIdx.x * NWAVE + wid, nw = gridDim.x * NWAVE;
    float ng[16];
#pragma unroll
    for (int j = 0; j < 16; ++j) ng[j] = p.gla_norm_g[(lane & 15) * 16 + j];
    constexpr int G3U = 4;
    for (int t0 = gw; t0 < T * REP_G3; t0 += nw * G3U) {
        uint4 ov[G3U][2], gv[G3U][2];
#pragma unroll
        for (int u = 0; u < G3U; ++u) {
            const int t = min(t0 + u * nw, T * REP_G3 - 1) & (T - 1);
            const uint4* orow = (const uint4*)(O + (size_t)t * 1024 + lane * 16);
            const uint4* grow = (const uint4*)(OG + (size_t)t * 1024 + lane * 16);
            ov[u][0] = orow[0]; ov[u][1] = orow[1]; gv[u][0] = grow[0]; gv[u][1] = grow[1];
        }
#pragma unroll
        for (int u = 0; u < G3U; ++u) {
            if (t0 + u * nw >= T * REP_G3) break;
            const int t = (t0 + u * nw) & (T - 1);
            float of[16], gf[16];
#pragma unroll
            for (int q = 0; q < 2; ++q) {
                const unsigned ow[4] = {ov[u][q].x, ov[u][q].y, ov[u][q].z, ov[u][q].w}, gw4[4] = {gv[u][q].x, gv[u][q].y, gv[u][q].z, gv[u][q].w};
#pragma unroll
                for (int k = 0; k < 4; ++k) { of[q * 8 + 2 * k] = bf_lo(ow[k]); of[q * 8 + 2 * k + 1] = bf_hi(ow[k]); gf[q * 8 + 2 * k] = bf_lo(gw4[k]); gf[q * 8 + 2 * k + 1] = bf_hi(gw4[k]); }
            }
            float ss = 0.f;
#pragma unroll
            for (int j = 0; j < 16; ++j) ss += of[j] * of[j];
            ss = dpp_sum16(ss);
            const float rinv = rsqrtf(ss * (1.f / 256.f) + EPS);
            float r[16];
#pragma unroll
            for (int j = 0; j < 16; ++j) r[j] = of[j] * rinv * ng[j] * silu(gf[j]);
            unsigned w[4];
#pragma unroll
            for (int q = 0; q < 4; ++q)
                w[q] = (unsigned)__builtin_amdgcn_cvt_pk_fp8_f32(r[4 * q + 2] * ON8_SCALE, r[4 * q + 3] * ON8_SCALE, __builtin_amdgcn_cvt_pk_fp8_f32(r[4 * q] * ON8_SCALE, r[4 * q + 1] * ON8_SCALE, 0, false), true);
            *(uint4*)((unsigned char*)ON + (size_t)t * 1024 + lane * 16) = make_uint4(w[0], w[1], w[2], w[3]);
        }
    }
}

#define HD __device__ __forceinline__
#define EXPF __expf
#ifndef HD
#define HD __host__ __device__ __forceinline__
#endif
HD unsigned umax_(unsigned a, unsigned b) { return a > b ? a : b; }
HD unsigned umin_(unsigned a, unsigned b) { return a < b ? a : b; }
HD unsigned f2ord(float f) { return __builtin_bit_cast(unsigned, f); }
HD float ord2f(unsigned u) { return __builtin_bit_cast(float, u); }
struct Ce16 { unsigned char i, j; };
constexpr Ce16 OE16[63] = {{0,1}, {2,3}, {0,2}, {1,3}, {1,2}, {4,5}, {6,7}, {4,6}, {5,7}, {5,6}, {0,4}, {2,6}, {2,4}, {1,5}, {3,7}, {3,5}, {1,2}, {3,4}, {5,6}, {8,9}, {10,11}, {8,10}, {9,11}, {9,10},
    {12,13}, {14,15}, {12,14}, {13,15}, {13,14}, {8,12}, {10,14}, {10,12}, {9,13}, {11,15}, {11,13}, {9,10}, {11,12}, {13,14}, {0,8}, {4,12}, {4,8}, {2,10}, {6,14}, {6,10}, {2,4}, {6,8}, {10,12},
    {1,9}, {5,13}, {5,9}, {3,11}, {7,15}, {7,11}, {3,5}, {7,9}, {11,13}, {1,2}, {3,4}, {5,6}, {7,8}, {9,10}, {11,12}, {13,14}};
template <int OFF> HD void sort16_desc(unsigned (&k)[64]) {
#pragma unroll
    for (int c = 0; c < 63; ++c) {
        const unsigned a = k[OFF + OE16[c].i], b = k[OFF + OE16[c].j];
        k[OFF + OE16[c].i] = umax_(a, b); k[OFF + OE16[c].j] = umin_(a, b);
    }
}
HD void merge16(unsigned* a, const unsigned* b) {
#pragma unroll
    for (int i = 0; i < 16; ++i) a[i] = umax_(a[i], b[15 - i]);
#pragma unroll
    for (int stride = 8; stride > 0; stride >>= 1)
#pragma unroll
        for (int i = 0; i < 16; ++i) {
            const int j = i ^ stride;
            if (j > i) { const unsigned x = a[i], y = a[j]; a[i] = umax_(x, y); a[j] = umin_(x, y); }
        }
}
HD void top16_of_64(unsigned (&k)[64]) {
    sort16_desc<0>(k); sort16_desc<16>(k); sort16_desc<32>(k); sort16_desc<48>(k);
    merge16(&k[0], &k[16]); merge16(&k[32], &k[48]); merge16(&k[0], &k[32]);
}
HD void route_select(const unsigned* a1, const unsigned* a2, int* e_out, float* g_out) {
    float v1[16], v2[16];
#pragma unroll
    for (int i = 0; i < 16; ++i) { v1[i] = ord2f(a1[i] & ~127u); v2[i] = ord2f(a2[i] & ~127u); }
    unsigned c[64];
    {
        int cnt = 0;
#pragma unroll
        for (int i = 0; i < 16; ++i)
#pragma unroll
            for (int j = 0; j < 16; ++j)
                if ((i + 1) * (j + 1) <= 16) { c[cnt] = (f2ord(v1[i] + v2[j]) & ~255u) | (unsigned)(i * 16 + j); ++cnt; }
#pragma unroll
        for (int q = 50; q < 64; ++q) c[q] = 0u;
    }
    top16_of_64(c);
    unsigned p1[4], p2[4];
#pragma unroll
    for (int q = 0; q < 4; ++q) {
        p1[q] = (a1[4 * q] & 127u) | ((a1[4 * q + 1] & 127u) << 8) | ((a1[4 * q + 2] & 127u) << 16) | ((a1[4 * q + 3] & 127u) << 24);
        p2[q] = (a2[4 * q] & 127u) | ((a2[4 * q + 1] & 127u) << 8) | ((a2[4 * q + 2] & 127u) << 16) | ((a2[4 * q + 3] & 127u) << 24);
    }
    float cs[16]; float sum = 0.f;
    const float mx = ord2f(c[0] & ~255u);
#pragma unroll
    for (int w = 0; w < 16; ++w) {
        const unsigned code = c[w] & 255u, i = code >> 4, j = code & 15u;
        const unsigned wi = (i >> 2) == 0 ? p1[0] : (i >> 2) == 1 ? p1[1] : (i >> 2) == 2 ? p1[2] : p1[3];
        const unsigned wj = (j >> 2) == 0 ? p2[0] : (j >> 2) == 1 ? p2[1] : (j >> 2) == 2 ? p2[2] : p2[3];
        const unsigned n1 = (wi >> (8 * (i & 3))) & 127u, n2 = (wj >> (8 * (j & 3))) & 127u;
        e_out[w] = (int)(n1 * 128u + n2);
        cs[w] = EXPF(ord2f(c[w] & ~255u) - mx); sum += cs[w];
    }
    const float inv = 1.f / sum;
#pragma unroll
    for (int w = 0; w < 16; ++w) g_out[w] = cs[w] * inv;
}

constexpr int RLD = 136;
__device__ __forceinline__ void route_load_q(bf16x8 (&bq)[8], const bf16_t* QP, size_t tok, int h, int set, int hh) {
#pragma unroll
    for (int ks = 0; ks < 8; ++ks) bq[ks] = *(const bf16x8*)(QP + tok * 2048 + h * 256 + set * 128 + 16 * ks + 8 * hh);
}
__device__ __forceinline__ void route_set_top16(const bf16x8 (&bq)[8], const bf16_t* sk_s, int set, int tl, int hh, unsigned (&out)[16]) {
    unsigned k[64];
#pragma unroll
    for (int nt = 0; nt < 4; ++nt) {
        f32x16 acc;
#pragma unroll
        for (int r = 0; r < 16; ++r) acc[r] = 16.f;
#pragma unroll
        for (int ks = 0; ks < 8; ++ks) {
            const bf16x8 aq = *(const bf16x8*)(sk_s + (set * 128 + 32 * nt + tl) * RLD + 16 * ks + 8 * hh);
            acc = __builtin_amdgcn_mfma_f32_32x32x16_bf16(aq, bq[ks], acc, 0, 0, 0);
        }
#pragma unroll
        for (int r = 0; r < 16; ++r) {
            const unsigned n = 32 * nt + (r & 3) + 8 * (r >> 2) + 4 * hh;
            k[nt * 16 + r] = (f2ord(acc[r]) & ~127u) | n;
        }
        __builtin_amdgcn_sched_barrier(0);
    }
    top16_of_64(k);
    unsigned pk[16];
#pragma unroll
    for (int i = 0; i < 16; ++i) pk[i] = (unsigned)__shfl_xor((int)k[i], 32);
    merge16(k, pk);
#pragma unroll
    for (int i = 0; i < 16; ++i) out[i] = k[i];
}
__device__ __forceinline__ void phase_route(const int wv, const Params& p, char* lds, const bf16_t* QP, int layer, unsigned* RT) {
    const int tid = opaque_tid(wv), lane = tid & 63, wid = tid >> 6, tl = lane & 31, hh = lane >> 5;
    bf16_t* sk_s = (bf16_t*)lds;
    {
        const uint4* src = (const uint4*)(p.ws + OFF_WB + WB_SUBK + (size_t)layer * 2 * 128 * 128 * 2);
        for (int i = tid; i < 2 * 128 * 16; i += NTHR) { const int row = i >> 4, ch = i & 15; *(uint4*)(sk_s + row * RLD + ch * 8) = src[i]; }
    }
    __syncthreads();
    for (int item0 = blockIdx.x; item0 < (T / 256) * 4 * REP_ROUTE; item0 += gridDim.x) {
        const int item = item0 % ((T / 256) * 4);
        const int tile = item >> 2, hp = item & 3;
        const size_t tok = (size_t)tile * 256 + 32 * wid + tl;
        unsigned a1[16], a2[16];
        {
            unsigned b1[16], b2[16];
            bf16x8 qa[8], qb[8];
            route_load_q(qa, QP, tok, 2 * hp, 0, hh);
            route_load_q(qb, QP, tok, 2 * hp, 1, hh);
            __builtin_amdgcn_sched_barrier(0);
            route_set_top16(qa, sk_s, 0, tl, hh, a1);
            __builtin_amdgcn_sched_barrier(0);
            route_load_q(qa, QP, tok, 2 * hp + 1, 0, hh);
            __builtin_amdgcn_sched_barrier(0);
            route_set_top16(qb, sk_s, 1, tl, hh, a2);
            __builtin_amdgcn_sched_barrier(0);
            route_load_q(qb, QP, tok, 2 * hp + 1, 1, hh);
            __builtin_amdgcn_sched_barrier(0);
            route_set_top16(qa, sk_s, 0, tl, hh, b1);
            __builtin_amdgcn_sched_barrier(0);
            route_set_top16(qb, sk_s, 1, tl, hh, b2);
            __builtin_amdgcn_sched_barrier(0);
#pragma unroll
            for (int i = 0; i < 16; ++i) { a1[i] = hh ? b1[i] : a1[i]; a2[i] = hh ? b2[i] : a2[i]; }
        }
        int e[16]; float g[16];
        route_select(a1, a2, e, g);
        const size_t o = (tok * 8 + 2 * hp + hh) * 16;
#pragma unroll
        for (int q = 0; q < 4; ++q) {
            uint4 v;
            v.x = ((unsigned)e[4 * q] << 16) | (pack2(g[4 * q], 0.f) & 0xFFFFu); v.y = ((unsigned)e[4 * q + 1] << 16) | (pack2(g[4 * q + 1], 0.f) & 0xFFFFu);
            v.z = ((unsigned)e[4 * q + 2] << 16) | (pack2(g[4 * q + 2], 0.f) & 0xFFFFu); v.w = ((unsigned)e[4 * q + 3] << 16) | (pack2(g[4 * q + 3], 0.f) & 0xFFFFu);
            *(uint4*)(RT + o + 4 * q) = v;
        }
    }
}

HD void s128_inreg(unsigned (&k)[8], int li, int size, int stride) {
#pragma unroll
    for (int r = 0; r < 8; ++r) {
        const int r2 = r ^ stride;
        if (r2 > r) {
            const int i = li * 8 + r;
            const bool asc = ((i & size) == 0);
            const unsigned a = k[r], b = k[r2];
            const unsigned lo = umin_(a, b), hi = umax_(a, b);
            k[r] = asc ? lo : hi; k[r2] = asc ? hi : lo;
        }
    }
}
HD void s128_xlane(unsigned (&k)[8], const unsigned (&pk)[8], int li, int size, int m) {
    const bool lower = ((li & m) == 0);
    const bool asc = (((li * 8) & size) == 0);
    const bool keepmin = (lower == asc);
#pragma unroll
    for (int r = 0; r < 8; ++r) k[r] = keepmin ? umin_(k[r], pk[r]) : umax_(k[r], pk[r]);
}

template <int M> __device__ __forceinline__ unsigned xor16(unsigned v) {
    if (M == 1) return (unsigned)__builtin_amdgcn_mov_dpp((int)v, 0xB1, 0xf, 0xf, true);
    if (M == 2) return (unsigned)__builtin_amdgcn_mov_dpp((int)v, 0x4E, 0xf, 0xf, true);
    if (M == 4) return (unsigned)__builtin_amdgcn_mov_dpp(__builtin_amdgcn_mov_dpp((int)v, 0x141, 0xf, 0xf, true), 0x1B, 0xf, 0xf, true);
    return (unsigned)__builtin_amdgcn_mov_dpp((int)v, 0x128, 0xf, 0xf, true);
}
template <int M> __device__ __forceinline__ void s128_xstage(unsigned (&k)[8], int li, int size) {
    unsigned pk[8];
#pragma unroll
    for (int r = 0; r < 8; ++r) pk[r] = xor16<M>(k[r]);
    s128_xlane(k, pk, li, size, M);
}
typedef float f32x2 __attribute__((ext_vector_type(2)));
typedef _Float16 h16x2 __attribute__((ext_vector_type(2)));
struct Row4 { uint4 c[4]; };
struct RowV { uint4 c[2]; };
__device__ __forceinline__ RowV peer_load_rowv1k(const unsigned char* tab, unsigned e, int li) {
    RowV r; const unsigned char* row = tab + (size_t)e * 1024 + li * 16;
    r.c[0] = *(const uint4*)(row); r.c[1] = *(const uint4*)(row + 256);
    return r;
}
__device__ __forceinline__ void peer_vgroup(const RowV& r0, const RowV& r1, const RowV& r2, const RowV& r3, int w4, int (&acc)[32]) {
#pragma unroll
    for (int c2 = 0; c2 < 2; ++c2) {
        const unsigned a[4] = {r0.c[c2].x, r0.c[c2].y, r0.c[c2].z, r0.c[c2].w}, b[4] = {r1.c[c2].x, r1.c[c2].y, r1.c[c2].z, r1.c[c2].w};
        const unsigned c[4] = {r2.c[c2].x, r2.c[c2].y, r2.c[c2].z, r2.c[c2].w}, d[4] = {r3.c[c2].x, r3.c[c2].y, r3.c[c2].z, r3.c[c2].w};
#pragma unroll
        for (int q = 0; q < 4; ++q) {
            const unsigned t0 = __builtin_amdgcn_perm(b[q], a[q], 0x05010400u), t1 = __builtin_amdgcn_perm(b[q], a[q], 0x07030602u);
            const unsigned t2 = __builtin_amdgcn_perm(d[q], c[q], 0x05010400u), t3 = __builtin_amdgcn_perm(d[q], c[q], 0x07030602u);
            const unsigned o0 = __builtin_amdgcn_perm(t2, t0, 0x05040100u), o1 = __builtin_amdgcn_perm(t2, t0, 0x07060302u);
            const unsigned o2 = __builtin_amdgcn_perm(t3, t1, 0x05040100u), o3 = __builtin_amdgcn_perm(t3, t1, 0x07060302u);
            const int k = (c2 * 4 + q) * 4;
            acc[k + 0] = __builtin_amdgcn_sdot4((int)o0, w4, acc[k + 0], false); acc[k + 1] = __builtin_amdgcn_sdot4((int)o1, w4, acc[k + 1], false);
            acc[k + 2] = __builtin_amdgcn_sdot4((int)o2, w4, acc[k + 2], false); acc[k + 3] = __builtin_amdgcn_sdot4((int)o3, w4, acc[k + 3], false);
        }
    }
}
__device__ __forceinline__ RowV peer_load_rowv(const unsigned char* tab, unsigned e, int li) {
    RowV r; const unsigned char* row = tab + (size_t)e * 512 + li * 16;
    r.c[0] = *(const uint4*)(row); r.c[1] = *(const uint4*)(row + 256);
    return r;
}
#ifndef PEER_RING
#define PEER_RING 4
#endif
#ifndef PEER_RING_U
#define PEER_RING_U 8
#endif
__device__ __forceinline__ Row4 peer_load_row(const unsigned char* tab, unsigned e, int li) {
    Row4 r; const unsigned char* row = tab + (size_t)e * 1024 + li * 16;
#pragma unroll
    for (int c = 0; c < 4; ++c) r.c[c] = *(const uint4*)(row + c * 256);
    return r;
}
template <int MODE, bool PROBE = false>
__device__ __forceinline__ void phase_peer(const int wv, const Params& p, char* lds, int layer, const bf16_t* H2, const bf16_t* XIN, const unsigned* RT,
                                           const float* g2, bf16_t* XOUT, bf16_t* HKV, bf16_t* HQ) {
    const int tid = opaque_tid(wv), lane0 = tid & 63, wid = tid >> 6;
    const int gw = blockIdx.x * NWAVE + wid, nw = gridDim.x * NWAVE;
    const unsigned char* U = (const unsigned char*)(p.ws + OFF_TBU) + (size_t)layer * NEXP * 512;
    const unsigned char* V = (const unsigned char*)(p.ws + OFF_TBV) + (size_t)layer * NEXP * 1024;
    const float* modv = (const float*)(p.ws + OFF_MOD);
    const float* kvmod = modv + 2 * 8 * 6144;
    const int peer_total = (T / 4) * REP_PEER, peer_rounds = (peer_total + nw - 1) / nw;
#define PEER_BARRIER() do { asm volatile("s_waitcnt lgkmcnt(0)" ::: "memory"); __builtin_amdgcn_s_barrier(); asm volatile("" ::: "memory"); } while (0)
#define PEER_PREFETCH(tt_, li_) do { const unsigned* rp_ = RT + (size_t)(tt_) * 128 + (li_) * 8; nk0 = *(const uint4*)rp_; nk1 = *(const uint4*)(rp_ + 4); \
        const bf16_t* hp_ = H2 + (size_t)(tt_) * 1024 + (li_) * 4;     \
        PEER_LDH(nh0, 0); PEER_LDH(nh1, 1); PEER_LDH(nh2, 2); PEER_LDH(nh3, 3); PEER_LDH(nh4, 4); PEER_LDH(nh5, 5); PEER_LDH(nh6, 6); PEER_LDH(nh7, 7); } while (0)
#define PEER_LDH(dst_, X_) do { const uint2 a_ = *(const uint2*)(hp_ + 256 * ((X_) >> 1) + 128 * ((X_) & 1)), b_ = *(const uint2*)(hp_ + 256 * ((X_) >> 1) + 128 * ((X_) & 1) + 64); dst_ = make_uint4(a_.x, a_.y, b_.x, b_.y); } while (0)
    uint4 nk0, nk1, nh0, nh1, nh2, nh3, nh4, nh5, nh6, nh7;
    { const int tb_ = min(gw, peer_total - 1) & (T / 4 - 1); PEER_PREFETCH(tb_ * 4 + (lane0 >> 4), lane0 & 15); }
    for (int rnd = 0; rnd < peer_rounds; ++rnd) {
        const int tb0 = min(gw + rnd * nw, peer_total - 1);
        const int tb = tb0 & (T / 4 - 1);
        int lane = lane0; asm volatile("" : "+v"(lane));
        const int grp = lane >> 4, li = lane & 15;
        const int t = tb * 4 + grp, b = t >> 13;
        const uint4 ck0 = nk0, ck1 = nk1, ch0 = nh0, ch1 = nh1, ch2 = nh2, ch3 = nh3, ch4 = nh4, ch5 = nh5, ch6 = nh6, ch7 = nh7;
        { const int tbn = min(gw + min(rnd + 1, peer_rounds - 1) * nw, peer_total - 1) & (T / 4 - 1); PEER_PREFETCH(tbn * 4 + grp, li); }
        unsigned kk[8];
        {
            const uint4 k0 = ck0, k1 = ck1;
            kk[0] = k0.x; kk[1] = k0.y; kk[2] = k0.z; kk[3] = k0.w; kk[4] = k1.x; kk[5] = k1.y; kk[6] = k1.z; kk[7] = k1.w;
            if (PROBE) {
#pragma unroll
                for (int r = 0; r < 8; ++r) kk[r] &= 0x00FFFFFFu;
            }
            s128_inreg(kk, li, 2, 1);
            s128_inreg(kk, li, 4, 2);
            s128_inreg(kk, li, 4, 1);
            s128_inreg(kk, li, 8, 4);
            s128_inreg(kk, li, 8, 2);
            s128_inreg(kk, li, 8, 1);
            s128_xstage<1>(kk, li, 16);
            s128_inreg(kk, li, 16, 4);
            s128_inreg(kk, li, 16, 2);
            s128_inreg(kk, li, 16, 1);
            s128_xstage<2>(kk, li, 32);
            s128_xstage<1>(kk, li, 32);
            s128_inreg(kk, li, 32, 4);
            s128_inreg(kk, li, 32, 2);
            s128_inreg(kk, li, 32, 1);
            s128_xstage<4>(kk, li, 64);
            s128_xstage<2>(kk, li, 64);
            s128_xstage<1>(kk, li, 64);
            s128_inreg(kk, li, 64, 4);
            s128_inreg(kk, li, 64, 2);
            s128_inreg(kk, li, 64, 1);
            s128_xstage<8>(kk, li, 128);
            s128_xstage<4>(kk, li, 128);
            s128_xstage<2>(kk, li, 128);
            s128_xstage<1>(kk, li, 128);
            s128_inreg(kk, li, 128, 4);
            s128_inreg(kk, li, 128, 2);
            s128_inreg(kk, li, 128, 1);
        }
        unsigned* pick_s = (unsigned*)lds + (wid * 4 + grp) * 256;
        float* aw_s = (float*)(pick_s + 128);
        *(uint4*)(pick_s + li * 8) = make_uint4(kk[0], kk[1], kk[2], kk[3]);
        *(uint4*)(pick_s + li * 8 + 4) = make_uint4(kk[4], kk[5], kk[6], kk[7]);
        PEER_BARRIER();
        {
            int hH[8], hL[8]; float inv_scale;
            RowV R[PEER_RING_U];
#pragma unroll
            for (int j = 0; j < PEER_RING_U - 1; ++j) R[j] = peer_load_rowv(U, pick_s[j] >> 16, li);
            {
                float hf[64]; float amax = 0.f;
                const uint4 hrow[8] = {ch0, ch1, ch2, ch3, ch4, ch5, ch6, ch7};
#pragma unroll
                for (int c = 0; c < 2; ++c)
#pragma unroll
                    for (int q = 0; q < 4; ++q) {
                        const uint4 h0 = hrow[c * 4 + q];
                        const unsigned w[4] = {h0.x, h0.y, h0.z, h0.w};
#pragma unroll
                        for (int k = 0; k < 4; ++k) { hf[c * 32 + 8 * q + 2 * k] = bf_lo(w[k]); hf[c * 32 + 8 * q + 2 * k + 1] = bf_hi(w[k]); }
                    }
                {
                    {
                        uint4* hk = (uint4*)(lds + 32768) + (size_t)((wid * 4 + grp) * 16 + li) * 8;
#pragma unroll
                        for (int X = 0; X < 8; ++X) hk[X] = hrow[X];
                    }
                    float hs = 0.f;
#pragma unroll
                    for (int q = 0; q < 64; ++q) hs = fmaf(hf[q], hf[q], hs);
                    const float hr = rsqrtf(dpp_sum16(hs) * (1.f / D) + EPS);
                    const bf16_t* cm2 = (const bf16_t*)(p.ws + OFF_CMB2) + (size_t)(layer * NB + b) * 2048 + li * 4;
#pragma unroll
                    for (int c = 0; c < 2; ++c)
#pragma unroll
                        for (int q = 0; q < 4; ++q) {
                            const int eo = 256 * (2 * c + (q >> 1)) + 128 * (q & 1);
                            const uint2 g0 = *(const uint2*)(cm2 + eo), g1 = *(const uint2*)(cm2 + eo + 64), s0 = *(const uint2*)(cm2 + 1024 + eo), s1 = *(const uint2*)(cm2 + 1024 + eo + 64);
                            const unsigned gw[4] = {g0.x, g0.y, g1.x, g1.y}, sw[4] = {s0.x, s0.y, s1.x, s1.y};
#pragma unroll
                            for (int k = 0; k < 4; ++k) {
                                hf[c * 32 + 8 * q + 2 * k] = fmaf(hf[c * 32 + 8 * q + 2 * k] * hr, bf_lo(gw[k]), bf_lo(sw[k]));
                                hf[c * 32 + 8 * q + 2 * k + 1] = fmaf(hf[c * 32 + 8 * q + 2 * k + 1] * hr, bf_hi(gw[k]), bf_hi(sw[k]));
                            }
                        }
                }
#pragma unroll
                for (int q = 0; q < 64; ++q) amax = fmaxf(amax, fabsf(hf[q]));
                amax = fmaxf(dpp_max16(amax), 1e-20f);
                const float sh = 119.f / amax;
                inv_scale = amax * (1.f / (119.f * TBU_SCALE));
#pragma unroll
                for (int d = 0; d < 8; ++d) {
                    unsigned wH = 0u, wL = 0u;
#pragma unroll
                    for (int k = 0; k < 8; ++k) {
                        const int h8 = __float2int_rn(hf[8 * d + k] * sh);
                        const int hh = (h8 + 8) >> 4;
                        const int hl = h8 - 16 * hh;
                        wH |= ((unsigned)hh & 15u) << (4 * k); wL |= ((unsigned)hl & 15u) << (4 * k);
                    }
                    hH[d] = (int)wH; hL[d] = (int)wL;
                }
            }
#pragma unroll 1
            for (int s0 = 0; s0 < 128; s0 += PEER_RING_U) {
#pragma unroll
                for (int j = 0; j < PEER_RING_U; ++j) {
                    const int s = s0 + j;
                    if (s + PEER_RING_U - 1 < 128) R[(j + PEER_RING_U - 1) % PEER_RING_U] = peer_load_rowv(U, pick_s[s + PEER_RING_U - 1] >> 16, li);
                    int accH = 0, accL = 0;
#pragma unroll
                    for (int c = 0; c < 2; ++c) {
                        const int uw[4] = {(int)R[j].c[c].x, (int)R[j].c[c].y, (int)R[j].c[c].z, (int)R[j].c[c].w};
#pragma unroll
                        for (int q = 0; q < 4; ++q) {
                            accH = __builtin_amdgcn_sdot8(uw[q], hH[c * 4 + q], accH, false);
                            accL = __builtin_amdgcn_sdot8(uw[q], hL[c * 4 + q], accL, false);
                        }
                    }
                    const float a = dpp_sum16((float)(16 * accH + accL)) * inv_scale;
                    if (li == 0) aw_s[s] = a;
                }
            }
        }
        RowV A0 = peer_load_rowv1k(V, pick_s[0] >> 16, li), A1 = peer_load_rowv1k(V, pick_s[1] >> 16, li), A2 = peer_load_rowv1k(V, pick_s[2] >> 16, li), A3 = peer_load_rowv1k(V, pick_s[3] >> 16, li);
        float wscale;
        {
            const float4 a0 = *(const float4*)(aw_s + li * 8), a1 = *(const float4*)(aw_s + li * 8 + 4);
            const float av[8] = {a0.x, a0.y, a0.z, a0.w, a1.x, a1.y, a1.z, a1.w};
            float wv[8]; float wmax = 0.f;
#pragma unroll
            for (int r = 0; r < 8; ++r) {
                const float a = av[r];
                wv[r] = __uint_as_float(kk[r] << 16) * 0.5f * a * (1.f + erff(a * 0.7071067811865476f));
                wmax = fmaxf(wmax, fabsf(wv[r]));
            }
            wmax = fmaxf(dpp_max16(wmax), 1e-30f);
            const float ws = 127.f / wmax;
            wscale = wmax * (1.f / (127.f * TBV_SCALE));
            int* iw_s = (int*)aw_s;
            const unsigned w_lo = q8(wv[0] * ws) | (q8(wv[1] * ws) << 8) | (q8(wv[2] * ws) << 16) | (q8(wv[3] * ws) << 24);
            const unsigned w_hi = q8(wv[4] * ws) | (q8(wv[5] * ws) << 8) | (q8(wv[6] * ws) << 16) | (q8(wv[7] * ws) << 24);
            __builtin_amdgcn_s_waitcnt(0xc07f);
            *(uint2*)(iw_s + 2 * li) = make_uint2(w_lo, w_hi);
        }
        PEER_BARRIER();
        float y[64];
        uint2 xu[16];
        {
            const int* iw_s = (const int*)aw_s;
#pragma unroll
            for (int hs = 0; hs < 2; ++hs) {
                const unsigned char* Vh = V + hs * 512;
                int acc[32];
#pragma unroll
                for (int q = 0; q < 32; ++q) acc[q] = 0;
#pragma unroll 1
                for (int j2 = 0; j2 < 32; j2 += 2) {
                    const int p1 = 4 * (j2 + 1);
                    const RowV B0 = peer_load_rowv1k(Vh, pick_s[p1] >> 16, li), B1 = peer_load_rowv1k(Vh, pick_s[p1 + 1] >> 16, li), B2 = peer_load_rowv1k(Vh, pick_s[p1 + 2] >> 16, li), B3 = peer_load_rowv1k(Vh, pick_s[p1 + 3] >> 16, li);
                    peer_vgroup(A0, A1, A2, A3, iw_s[j2], acc);
                    const int p2 = 4 * ((j2 + 2) & 31);
                    const unsigned char* Vn = (j2 + 2 < 32) ? Vh : V + 512;
                    A0 = peer_load_rowv1k(Vn, pick_s[p2] >> 16, li); A1 = peer_load_rowv1k(Vn, pick_s[p2 + 1] >> 16, li); A2 = peer_load_rowv1k(Vn, pick_s[p2 + 2] >> 16, li); A3 = peer_load_rowv1k(Vn, pick_s[p2 + 3] >> 16, li);
                    peer_vgroup(B0, B1, B2, B3, iw_s[j2 + 1], acc);
                }
#pragma unroll
                for (int q = 0; q < 32; ++q) y[hs * 32 + q] = (float)acc[q] * wscale;
            }
        }
        {
            const uint4* hk = (const uint4*)(lds + 32768) + (size_t)((wid * 4 + grp) * 16 + li) * 8;
#pragma unroll
            for (int X = 0; X < 8; ++X) { const uint4 h_ = hk[X]; xu[2 * X] = make_uint2(h_.x, h_.y); xu[2 * X + 1] = make_uint2(h_.z, h_.w); }
        }
        float ss = 0.f;
        {
            float4 ga[16];
#pragma unroll
            for (int c = 0; c < 4; ++c)
#pragma unroll
                for (int q4 = 0; q4 < 4; ++q4) {
                    const int eo = 256 * c + 4 * li + 64 * q4;
                    ga[c * 4 + q4] = *(const float4*)(g2 + (size_t)b * 6144 + eo);
                }
#pragma unroll
            for (int cq = 0; cq < 16; ++cq) {
                const float4 xa = make_float4(bf_lo(xu[cq].x), bf_hi(xu[cq].x), bf_lo(xu[cq].y), bf_hi(xu[cq].y));
                const int yi = 4 * cq;
                y[yi + 0] = xa.x + ga[cq].x * y[yi + 0]; y[yi + 1] = xa.y + ga[cq].y * y[yi + 1]; y[yi + 2] = xa.z + ga[cq].z * y[yi + 2]; y[yi + 3] = xa.w + ga[cq].w * y[yi + 3];
                ss = fmaf(y[yi + 0], y[yi + 0], ss); ss = fmaf(y[yi + 1], y[yi + 1], ss); ss = fmaf(y[yi + 2], y[yi + 2], ss); ss = fmaf(y[yi + 3], y[yi + 3], ss);
            }
        }
        ss = dpp_sum16(ss);
        const float rinv = rsqrtf(ss * (1.f / D) + EPS);
#pragma unroll
        for (int c = 0; c < 4; ++c) {
            const int off = 256 * c + 4 * li;
            if (MODE == 0) {
#pragma unroll
                for (int q4 = 0; q4 < 4; ++q4) {
                    const float yy[4] = {y[c * 16 + 4 * q4 + 0], y[c * 16 + 4 * q4 + 1], y[c * 16 + 4 * q4 + 2], y[c * 16 + 4 * q4 + 3]};
                    if (!PROBE) { uint2 xo; xo.x = pack2(yy[0], yy[1]); xo.y = pack2(yy[2], yy[3]); *(uint2*)(XOUT + (size_t)t * D + off + 64 * q4) = xo; }
                    const bf16_t* cmb = (const bf16_t*)(p.ws + OFF_CMB) + (size_t)b * 4096 + off + 64 * q4;
                    const uint2 ka = *(const uint2*)cmb, kb = *(const uint2*)(cmb + 1024), qa = *(const uint2*)(cmb + 2048), qb = *(const uint2*)(cmb + 3072);
                    const float xn0 = yy[0] * rinv, xn1 = yy[1] * rinv, xn2 = yy[2] * rinv, xn3 = yy[3] * rinv;
                    const float k0 = xn0 * bf_lo(ka.x) + bf_lo(kb.x), k1 = xn1 * bf_hi(ka.x) + bf_hi(kb.x), k2 = xn2 * bf_lo(ka.y) + bf_lo(kb.y), k3 = xn3 * bf_hi(ka.y) + bf_hi(kb.y);
                    const float q0 = xn0 * bf_lo(qa.x) + bf_lo(qb.x), q1 = xn1 * bf_hi(qa.x) + bf_hi(qb.x), q2 = xn2 * bf_lo(qa.y) + bf_lo(qb.y), q3 = xn3 * bf_hi(qa.y) + bf_hi(qb.y);
                    const unsigned o1 = (unsigned)__builtin_amdgcn_cvt_pk_fp8_f32(k2 * H8_SCALE, k3 * H8_SCALE, __builtin_amdgcn_cvt_pk_fp8_f32(k0 * H8_SCALE, k1 * H8_SCALE, 0, false), true);
                    const unsigned o2 = (unsigned)__builtin_amdgcn_cvt_pk_fp8_f32(q2 * H8_SCALE, q3 * H8_SCALE, __builtin_amdgcn_cvt_pk_fp8_f32(q0 * H8_SCALE, q1 * H8_SCALE, 0, false), true);
                    if (!PROBE) { *(unsigned*)((unsigned char*)HKV + (size_t)t * D + off + 64 * q4) = o1; *(unsigned*)((unsigned char*)HQ + (size_t)t * D + off + 64 * q4) = o2; }
                    else asm volatile("" :: "v"(o1), "v"(o2));
                }
                __builtin_amdgcn_sched_barrier(0);
            } else {
#pragma unroll
                for (int q4 = 0; q4 < 4; ++q4) {
                    const float yy[4] = {y[c * 16 + 4 * q4 + 0], y[c * 16 + 4 * q4 + 1], y[c * 16 + 4 * q4 + 2], y[c * 16 + 4 * q4 + 3]};
                    const float4 fg = *(const float4*)(p.final_norm_g + off + 64 * q4);
                    if (!PROBE) *(float4*)(p.out + (size_t)t * D + off + 64 * q4) = make_float4(yy[0] * rinv * fg.x, yy[1] * rinv * fg.y, yy[2] * rinv * fg.z, yy[3] * rinv * fg.w);
                    else asm volatile("" :: "v"(yy[0] * rinv * fg.x), "v"(yy[1] * rinv * fg.y), "v"(yy[2] * rinv * fg.z), "v"(yy[3] * rinv * fg.w));
                }
            }
        }
    }
}

constexpr int AKLD = 72, AVLD = 264;
__device__ __forceinline__ void phase_swa(const int wv, const Params& p, char* lds, const bf16_t* QA, const bf16_t* KSH, const bf16_t* VTSH, bf16_t* OA) {
    const int tid = opaque_tid(wv), lane = tid & 63, wid = tid >> 6, ql = lane & 31, hh = lane >> 5;
    const int qs = wid & 3, hp = wid >> 2;
    bf16_t* K_s = (bf16_t*)lds;
    bf16_t* V_s = K_s + 256 * AKLD;
    for (int item0 = blockIdx.x; item0 < NB * 64 * 4 * REP_SWA; item0 += gridDim.x) {
        const int item = item0 % (NB * 64 * 4);
        const int kvh = item & 3, n = (item >> 2) & 63, b = item >> 8;
        __syncthreads();
#pragma unroll
        for (int i = 0; i < 4; ++i) {
            const int idx = tid + NTHR * i, row = idx >> 3, ch = idx & 7;
            uint4 v = make_uint4(0u, 0u, 0u, 0u);
            if (n > 0 || row >= 128) v = *(const uint4*)(KSH + ((size_t)b * SEQ + 128 * n - 128 + row) * 256 + kvh * 64 + ch * 8);
            *(uint4*)(K_s + row * AKLD + ch * 8) = v;
        }
#pragma unroll
        for (int i = 0; i < 4; ++i) {
            const int idx = tid + NTHR * i, row = idx >> 5, ch = idx & 31;
            uint4 v = make_uint4(0u, 0u, 0u, 0u);
            if (n > 0 || ch >= 16) v = *(const uint4*)(VTSH + ((size_t)b * 256 + kvh * 64 + row) * SEQ + 128 * n - 128 + ch * 8);
            *(uint4*)(V_s + row * AVLD + ch * 8) = v;
        }
        __syncthreads();
        const size_t tq = (size_t)b * SEQ + 128 * n + 32 * qs + ql;
#pragma unroll 1
        for (int gi = 0; gi < 2; ++gi) {
            const int head = kvh * 4 + hp * 2 + gi;
            const float sink = p.swa_sinks[head];
            bf16x8 bq[4];
#pragma unroll
            for (int ks = 0; ks < 4; ++ks) bq[ks] = *(const bf16x8*)(QA + tq * 1024 + head * 64 + 16 * ks + 8 * hh);
            f32x16 sc[5];
#pragma unroll
            for (int kt = 0; kt < 5; ++kt) {
#pragma unroll
                for (int r = 0; r < 16; ++r) sc[kt][r] = 0.f;
                const int m0 = 32 * (qs + kt);
#pragma unroll
                for (int ks = 0; ks < 4; ++ks) {
                    const bf16x8 ka = *(const bf16x8*)(K_s + (m0 + ql) * AKLD + 16 * ks + 8 * hh);
                    sc[kt] = __builtin_amdgcn_mfma_f32_32x32x16_bf16(ka, bq[ks], sc[kt], 0, 0, 0);
                }
                __builtin_amdgcn_sched_barrier(0);
            }
            float mx = -1e30f;
#pragma unroll
            for (int kt = 0; kt < 5; ++kt) {
                const bool tile_dead = (n == 0) && (qs + kt < 4);
#pragma unroll
                for (int r = 0; r < 16; ++r) {
                    const int rr = (r & 3) + 8 * (r >> 2) + 4 * hh;
                    bool valid = !tile_dead;
                    if (kt == 0) valid = valid && (rr > ql);
                    if (kt == 4) valid = valid && (rr <= ql);
                    const float s = valid ? sc[kt][r] : -1e30f;
                    sc[kt][r] = s; mx = fmaxf(mx, s);
                }
            }
            mx = fmaxf(mx, __shfl_xor(mx, 32));
            mx = fmaxf(mx, sink);
            float lsum = 0.f;
#pragma unroll
            for (int kt = 0; kt < 5; ++kt)
#pragma unroll
                for (int r = 0; r < 16; ++r) { const float pv = __expf(sc[kt][r] - mx); sc[kt][r] = pv; lsum += pv; }
            lsum += __shfl_xor(lsum, 32);
            const float inv = 1.f / (lsum + __expf(sink - mx));
            f32x16 oacc[2];
#pragma unroll
            for (int dt = 0; dt < 2; ++dt)
#pragma unroll
                for (int r = 0; r < 16; ++r) oacc[dt][r] = 0.f;
#pragma unroll
            for (int kt = 0; kt < 5; ++kt) {
                const int m0 = 32 * (qs + kt);
#pragma unroll
                for (int s = 0; s < 2; ++s) {
                    union { bf16x8 v; unsigned u[4]; } pf;
#pragma unroll
                    for (int j = 0; j < 4; ++j) pf.u[j] = pack2(sc[kt][8 * s + 2 * j], sc[kt][8 * s + 2 * j + 1]);
#pragma unroll
                    for (int dt = 0; dt < 2; ++dt) {
                        const bf16_t* vp = V_s + (32 * dt + ql) * AVLD + m0 + 16 * s + 4 * hh;
                        union { bf16x8 v; uint2 u[2]; } vf;
                        vf.u[0] = *(const uint2*)vp; vf.u[1] = *(const uint2*)(vp + 8);
                        oacc[dt] = __builtin_amdgcn_mfma_f32_32x32x16_bf16(vf.v, pf.v, oacc[dt], 0, 0, 0);
                    }
                    __builtin_amdgcn_sched_barrier(0);
                }
            }
            {
                const float is = inv * O8_SCALE;
                unsigned pc[2][4];
#pragma unroll
                for (int dt = 0; dt < 2; ++dt)
#pragma unroll
                    for (int g4 = 0; g4 < 4; ++g4)
                        pc[dt][g4] = (unsigned)__builtin_amdgcn_cvt_pk_fp8_f32(oacc[dt][4 * g4 + 2] * is, oacc[dt][4 * g4 + 3] * is, __builtin_amdgcn_cvt_pk_fp8_f32(oacc[dt][4 * g4] * is, oacc[dt][4 * g4 + 1] * is, 0, false), true);
#pragma unroll
                for (int g4 = 0; g4 < 4; ++g4) { const u32x2 r = __builtin_amdgcn_permlane32_swap(pc[0][g4], pc[1][g4], false, false); pc[0][g4] = r.x; pc[1][g4] = r.y; }
                unsigned char* op = (unsigned char*)OA + tq * 1024 + head * 64 + 32 * hh;
                *(uint4*)op = make_uint4(pc[0][0], pc[1][0], pc[0][1], pc[1][1]);
                *(uint4*)(op + 16) = make_uint4(pc[0][2], pc[1][2], pc[0][3], pc[1][3]);
            }
        }
    }
}

__global__ void __launch_bounds__(NTHR, 2) yoco_megakernel(Params p) {
    __shared__ __attribute__((aligned(16))) char lds[LDS_BYTES];
    cg::grid_group grid = cg::this_grid();
    int wv = __builtin_amdgcn_readfirstlane((int)threadIdx.x >> 6); asm volatile("" : "+s"(wv));
    volatile LAS unsigned* xb_words = (volatile LAS unsigned*)(lds + LDS_BYTES - 16);
    if (threadIdx.x == 0) { xb_words[0] = 0u; xb_words[1] = 0u; }
    __syncthreads();
    const XcdBarrier xb = xcd_barrier_post((unsigned*)p.ws, xb_words);
    float* modv = (float*)(p.ws + OFF_MOD);
    bf16_t* R0 = (bf16_t*)(p.ws + OFF_R0);
    bf16_t* X2 = R0 + (size_t)T * D;
    bf16_t* A0 = (bf16_t*)(p.ws + OFF_A0); bf16_t* A1 = (bf16_t*)(p.ws + OFF_A1); bf16_t* A2 = (bf16_t*)(p.ws + OFF_A2); bf16_t* A3 = (bf16_t*)(p.ws + OFF_A3);
    const bf16_t* WB = (const bf16_t*)(p.ws + OFF_WB);
    bf16_t* OBUF = (bf16_t*)p.out;
    bf16_t* PM = (bf16_t*)((char*)p.out + 128 * MiB);
    float* GL = (float*)((char*)p.out + 160 * MiB);
    float* DEC = (float*)((char*)p.out + 164 * MiB);
    unsigned* RT = (unsigned*)(p.ws + OFF_RTE);
    phase_prep(wv, p, lds);
    grid.sync();
    if (blockIdx.x < NB) {
        const int b = blockIdx.x; const float* kvmod = modv + 2 * 8 * 6144; bf16_t* cmb = (bf16_t*)(p.ws + OFF_CMB) + (size_t)b * 4096;
        for (int d = opaque_tid(wv); d < 1024; d += NTHR) {
            const float kvA = p.kv_norm_g[d] * (1.f + kvmod[b * 2048 + 1024 + d]), kvB = kvmod[b * 2048 + d];
            const float qA = p.norm_g[2 * 1024 + d] * (1.f + modv[(8 + b) * 6144 + 1024 + d]), qB = modv[(8 + b) * 6144 + d];
            cmb[d] = (bf16_t)(pack2(kvA, 0.f) & 0xFFFFu); cmb[1024 + d] = (bf16_t)(pack2(kvB, 0.f) & 0xFFFFu);
            cmb[2048 + d] = (bf16_t)(pack2(qA, 0.f) & 0xFFFFu); cmb[3072 + d] = (bf16_t)(pack2(qB, 0.f) & 0xFFFFu);
#pragma unroll
            for (int l = 0; l < 2; ++l) {
                bf16_t* cmb2 = (bf16_t*)(p.ws + OFF_CMB2) + (size_t)(l * NB + b) * 2048;
                cmb2[d] = (bf16_t)(pack2(p.norm_g[(l ? 3 : 1) * 1024 + d] * (1.f + modv[(l * 8 + b) * 6144 + 4096 + d]), 0.f) & 0xFFFFu);
                cmb2[1024 + d] = (bf16_t)(pack2(modv[(l * 8 + b) * 6144 + 3072 + d], 0.f) & 0xFFFFu);
            }
        }
    }
    phase_modulate<false>(wv, p.x, p.norm_g, modv + 0, modv + 1024, 6144, A0);
    xcd_barrier(xb);
    run_gemm(wv, lds, A0, WB + WB_MAIN / 2, T, 2304, EpiInMain{A1, A1 + (size_t)T * 512, A3, GL});
    run_gemm(wv, lds, WB + WB_V / 2, A0, 1024, T, EpiVT{A2, 1024, 1.f});
    xcd_barrier(xb);
    phase_gla_g1(wv, p, lds, GL, PM, DEC);
    xcd_barrier(xb);
    phase_gla_g2(wv, p, lds, PM, DEC, OBUF);
    xcd_barrier(xb);
    phase_gla_g3(wv, p, OBUF, A3, A2);
    xcd_barrier(xb);
    run_gemm8(wv, lds, (const unsigned char*)A2, (const unsigned char*)(p.ws + OFF_WB) + WB_WOUT, T, 1024, EpiResid<false>{p.x, modv + 2048, 6144, R0, 1.f / (ON8_SCALE * PWQ8_SCALE)});
    xcd_barrier(xb);
    phase_modulate<true>(wv, R0, p.norm_g + 1024, modv + 3072, modv + 4096, 6144, A0);
    xcd_barrier(xb);
    run_gemm(wv, lds, A0, WB + WB_PWQ / 2, T, 2048, EpiRowBf16{A1, 2048});
    xcd_barrier(xb);
    phase_route(wv, p, lds, A1, 0, RT);
    xcd_barrier(xb);
#ifdef PROBE_PEER
    phase_peer<0, true>(wv, p, lds, 0, A0, R0, RT, modv + 5 * 1024, X2, A1, A2);
#endif
    phase_peer<0>(wv, p, lds, 0, R0, R0, RT, modv + 5 * 1024, X2, A1, A2);
    xcd_barrier(xb);
    bf16_t* KSH = A0; bf16_t* VTSH = A0 + (size_t)T * 256;
    {
        const unsigned char* W8 = (const unsigned char*)(p.ws + OFF_WB);
        constexpr float SC = 1.f / (H8_SCALE * PWQ8_SCALE);
        run_gemm8(wv, lds, (const unsigned char*)A1, W8 + WB_KVK, T, 256, EpiRopeBf16{KSH, 256, SC, (const float*)(p.ws + OFF_ROPE)});
        run_gemm8(wv, lds, W8 + WB_KVV, (const unsigned char*)A1, 256, T, EpiVT{VTSH, 256, SC});
        run_gemm8(wv, lds, (const unsigned char*)A2, W8 + WB_SWAQ, T, 1024, EpiRopeBf16{A3, 1024, 0.125f * SC, (const float*)(p.ws + OFF_ROPE)});
    }
    xcd_barrier(xb);
    phase_swa(wv, p, lds, A3, KSH, VTSH, A1);
    xcd_barrier(xb);
    run_gemm8(wv, lds, (const unsigned char*)A1, (const unsigned char*)(p.ws + OFF_WB + WB_SWAO), T, 1024, EpiResid<true>{X2, modv + 8 * 6144 + 2048, 6144, R0, 1.f / (O8_SCALE * PWQ8_SCALE)});
    xcd_barrier(xb);
    phase_modulate<true>(wv, R0, p.norm_g + 3 * 1024, modv + 8 * 6144 + 3072, modv + 8 * 6144 + 4096, 6144, nullptr, (unsigned char*)A3);
    xcd_barrier(xb);
    run_gemm8(wv, lds, (const unsigned char*)A3, (const unsigned char*)(p.ws + OFF_WB) + WB_PWQ + 2048ull * 2048, T, 2048, EpiRowBf16S{A1, 2048, 1.f / (H8_SCALE * PWQ8_SCALE)});
    xcd_barrier(xb);
    phase_route(wv, p, lds, A1, 1, RT);
    xcd_barrier(xb);
#ifdef PROBE_PEER
    phase_peer<1, true>(wv, p, lds, 1, A0, R0, RT, modv + 8 * 6144 + 5 * 1024, nullptr, nullptr, nullptr);
#endif
    phase_peer<1>(wv, p, lds, 1, R0, R0, RT, modv + 8 * 6144 + 5 * 1024, nullptr, nullptr, nullptr);
}

extern "C" void kernel_launch(void* const* d_in, const int* in_sizes, int n_in, void* d_out, int out_size, void* d_ws, size_t ws_size,
                              hipStream_t stream) {
    if (ws_size < WS_NEED) { fprintf(stderr, "workspace too small: %zu < %zu\n", ws_size, (size_t)WS_NEED); return; }
    Params p{};
    p.x = (const float*)d_in[0]; p.c = (const float*)d_in[1]; p.pos = (const int*)d_in[2]; p.mod_w = (const float*)d_in[3];
    p.mod_b = (const float*)d_in[4]; p.norm_g = (const float*)d_in[5]; p.gla_w_in = (const float*)d_in[6]; p.gla_w_g2 = (const float*)d_in[7];
    p.gla_b_g2 = (const float*)d_in[8]; p.gla_norm_g = (const float*)d_in[9]; p.gla_w_out = (const float*)d_in[10];
    p.kv_mod_w = (const float*)d_in[11]; p.kv_mod_b = (const float*)d_in[12]; p.kv_norm_g = (const float*)d_in[13]; p.kv_w = (const float*)d_in[14];
    p.swa_w_q = (const float*)d_in[15]; p.swa_sinks = (const float*)d_in[16]; p.swa_w_out = (const float*)d_in[17];
    p.peer_w_q = (const float*)d_in[18]; p.peer_subkeys = (const float*)d_in[19]; p.peer_u = (const float*)d_in[20]; p.peer_v = (const float*)d_in[21];
    p.final_norm_g = (const float*)d_in[22];
    p.out = (float*)d_out; p.ws = (char*)d_ws;
    static int grid_blocks = 0;
    if (!grid_blocks) {
        int dev = 0, cus = 0, per_cu = 0;
        (void)hipGetDevice(&dev);
        (void)hipDeviceGetAttribute(&cus, hipDeviceAttributeMultiprocessorCount, dev);
        (void)hipOccupancyMaxActiveBlocksPerMultiprocessor(&per_cu, yoco_megakernel, NTHR, 0);
        if (per_cu < 1) fprintf(stderr, "occupancy query returned %d\n", per_cu);
        grid_blocks = cus;
    }
    (void)hipMemsetAsync(d_ws, 0, 16384, stream);
    void* args[] = {&p};
    hipError_t e = hipLaunchCooperativeKernel((void*)yoco_megakernel, dim3(grid_blocks), dim3(NTHR), args, 0, stream);
    if (e != hipSuccess) fprintf(stderr, "cooperative launch failed: %s (grid %d)\n", hipGetErrorString(e), grid_blocks);
}
```
